# Optimizing an MI355X kernel written in HIP

```python
import jax, jax.numpy as jnp
from jax import lax
import numpy as np

D_MODEL = 1024
BATCH = 2
SEQ = 8192
DEPTH = 2

CHUNK = 64
EPS = 1e-6
CONV_K = 3
SGU_WIDTH = 512
SGU_GROUPS = 8
SGU_HEAD = SGU_WIDTH // SGU_GROUPS
SGU_BLOCK = 128
CONV_WIDTH = 512
POOL_WIDTH = 512
POOL_WINDOWS = (2, 4, 8, 16)
POOL_GROUPS = len(POOL_WINDOWS)
POOL_HEAD = POOL_WIDTH // POOL_GROUPS
N_BRANCH = 3
IN_COLS = 2 * SGU_WIDTH + 3 * CONV_WIDTH + POOL_WIDTH + N_BRANCH * D_MODEL
D_FF = 2816

kernel_name = "hybrid_gated_gmlp_shortconv_pool_block"


def _rmsnorm(x, g):
    x32 = x.astype(jnp.float32)
    y = x32 * lax.rsqrt(jnp.mean(x32 * x32, axis=-1, keepdims=True) + EPS)
    return (y * g.astype(jnp.float32)).astype(x.dtype)


def _causal_dwconv(x, w):
    k = w.shape[0]
    s = x.shape[1]
    xp = jnp.pad(x, ((0, 0), (k - 1, 0), (0, 0)))
    y = xp[:, 0:s, :] * w[0]
    for i in range(1, k):
        y = y + xp[:, i:i + s, :] * w[i]
    return y


def _sgu(u, v, ln_g, w_s, b_s):
    bn, s, _ = u.shape
    nb = s // SGU_BLOCK
    v = v.reshape(bn, nb, SGU_BLOCK, SGU_GROUPS, SGU_HEAD)
    v32 = v.astype(jnp.float32)
    mu = jnp.mean(v32, axis=-1, keepdims=True)
    var = jnp.mean(jnp.square(v32 - mu), axis=-1, keepdims=True)
    vn = ((v32 - mu) * lax.rsqrt(var + EPS)).astype(u.dtype) * ln_g.reshape(SGU_GROUPS, SGU_HEAD)
    chunk_id = jnp.arange(SGU_BLOCK) // CHUNK
    mask = chunk_id[None, :] <= chunk_id[:, None]
    w = jnp.where(mask[None], w_s, 0)
    sp = jnp.einsum('gij,bnjgc->bnigc', w, vn) + b_s.T[None, None, :, :, None]
    return u * sp.reshape(bn, s, SGU_WIDTH)


def _pool_mixer(z, w_pool, scale):
    bn, s, _ = z.shape
    zg = z.reshape(bn, s, POOL_GROUPS, POOL_HEAD)
    cs = jnp.cumsum(zg.astype(jnp.float32), axis=1)
    t = jnp.arange(s, dtype=jnp.float32)
    outs = []
    for g, win in enumerate(POOL_WINDOWS):
        c = cs[:, :, g]
        prev = jnp.pad(c[:, :s - win], ((0, 0), (win, 0), (0, 0)))
        count = jnp.minimum(t + 1.0, float(win))[None, :, None]
        outs.append((c - prev) / count - zg[:, :, g].astype(jnp.float32))
    pooled = jnp.stack(outs, axis=2).astype(z.dtype)
    y = jnp.einsum('bsgc,gcd->bsgd', pooled, w_pool)
    return y.reshape(bn, s, POOL_WIDTH) * scale


def setup_inputs(seed: int = 0) -> dict:
    key = jax.random.key(seed)
    ks = jax.random.split(key, 20)
    f = jnp.float32
    n = lambda k, shp, sc: jax.random.normal(k, shp, f) * sc
    return {
        "x": n(ks[0], (BATCH, SEQ, D_MODEL), 1.0),
        "norm_mix": 1.0 + n(ks[1], (DEPTH, D_MODEL), 0.02),
        "w_in": n(ks[2], (DEPTH, D_MODEL, IN_COLS), D_MODEL ** -0.5),
        "sgu_ln": 1.0 + n(ks[3], (DEPTH, SGU_WIDTH), 0.02),
        "sgu_w": n(ks[4], (DEPTH, SGU_GROUPS, SGU_BLOCK, SGU_BLOCK), 0.5 * SGU_BLOCK ** -0.5),
        "sgu_b": 1.0 + n(ks[5], (DEPTH, SGU_GROUPS, SGU_BLOCK), 0.02),
        "conv_b_w": n(ks[6], (DEPTH, CONV_K, CONV_WIDTH), CONV_K ** -0.5),
        "pool_w": n(ks[7], (DEPTH, POOL_GROUPS, POOL_HEAD, POOL_HEAD), POOL_HEAD ** -0.5),
        "pool_scale": 1.0 + n(ks[8], (DEPTH, POOL_WIDTH), 0.02),
        "w_br_a": n(ks[9], (DEPTH, SGU_WIDTH, D_MODEL), SGU_WIDTH ** -0.5),
        "w_br_b": n(ks[10], (DEPTH, CONV_WIDTH, D_MODEL), CONV_WIDTH ** -0.5),
        "w_br_c": n(ks[11], (DEPTH, POOL_WIDTH, D_MODEL), POOL_WIDTH ** -0.5),
        "w_o": n(ks[12], (DEPTH, D_MODEL, D_MODEL), D_MODEL ** -0.5),
        "norm_ffn": 1.0 + n(ks[13], (DEPTH, D_MODEL), 0.02),
        "w_up": n(ks[14], (DEPTH, D_MODEL, 2 * D_FF), D_MODEL ** -0.5),
        "ffn_conv_w": n(ks[15], (DEPTH, CONV_K, 2 * D_FF), CONV_K ** -0.5),
        "w_down": n(ks[16], (DEPTH, D_FF, D_MODEL), D_FF ** -0.5),
        "norm_f": 1.0 + n(ks[17], (D_MODEL,), 0.02),
    }


def reference(x, norm_mix, w_in, sgu_ln, sgu_w, sgu_b, conv_b_w, pool_w, pool_scale,
              w_br_a, w_br_b, w_br_c, w_o, norm_ffn, w_up, ffn_conv_w, w_down, norm_f):
    bn, s, _ = x.shape
    splits = np.cumsum([SGU_WIDTH, SGU_WIDTH, CONV_WIDTH, CONV_WIDTH, CONV_WIDTH, POOL_WIDTH]).tolist()
    for l in range(DEPTH):
        h = _rmsnorm(x, norm_mix[l])
        p = h @ w_in[l]
        u, v, bg, cg, xb, zc, gl = jnp.split(p, splits, axis=-1)
        ya = _sgu(jax.nn.gelu(u, approximate=False), jax.nn.gelu(v, approximate=False),
                  sgu_ln[l], sgu_w[l], sgu_b[l])
        yb = bg * _causal_dwconv(cg * xb, conv_b_w[l])
        yc = _pool_mixer(zc, pool_w[l], pool_scale[l])
        g = jax.nn.sigmoid(gl).reshape(bn, s, N_BRANCH, D_MODEL)
        merged = (g[:, :, 0] * (ya @ w_br_a[l])
                  + g[:, :, 1] * (yb @ w_br_b[l])
                  + g[:, :, 2] * (yc @ w_br_c[l]))
        x = x + merged @ w_o[l]
        h = _rmsnorm(x, norm_ffn[l])
        a = _causal_dwconv(h @ w_up[l], ffn_conv_w[l])
        ag, av = jnp.split(a, 2, axis=-1)
        x = x + (jax.nn.silu(ag) * av) @ w_down[l]
    return _rmsnorm(x, norm_f)
```

```cpp
#include <hip/hip_runtime.h>
#include <hip/hip_cooperative_groups.h>
#include <cstdio>
#include <cstdint>
namespace cg = cooperative_groups;

namespace pg8 {
#define PG8_LAS __attribute__((address_space(3)))
typedef unsigned short bf16_t;
typedef short bf16x8 __attribute__((ext_vector_type(8)));
typedef float f32x4 __attribute__((ext_vector_type(4)));
typedef unsigned u32x4 __attribute__((ext_vector_type(4)));
typedef unsigned u32x2 __attribute__((ext_vector_type(2)));
constexpr int BM = 256, BK = 64, HALF = 128, HTB = HALF * BK * 2  , STAGE_BYTES = 8 * HTB, NXCD = 8, WGM = 8;

__host__ __device__ __forceinline__ int lds_byte(int r, int c) { const int st = (r >> 4) * 2 + (c >> 5), rr = r & 15, cc = c & 31, ob = rr * 64 + cc * 2; return st * 1024 + (ob ^ (((ob >> 9) & 1) << 5)); }
__host__ __device__ __forceinline__ void stage_rc(int b, int& R, int& C) { const int st = b / 1024, sb = b % 1024, swz = sb ^ (((sb >> 9) & 1) << 5); R = (st >> 1) * 16 + swz / 64; C = (st & 1) * 32 + (swz % 64) / 2; }
__host__ __device__ __forceinline__ int perm32(int rho) { const int n = rho >> 4, i = rho & 15; return 8 * (i >> 2) + 4 * n + (i & 3); }

struct Unit { int pm, pn, sub; size_t aoff, boff; };
struct Gemm { const bf16_t* A; const bf16_t* Bt; int lda, ldb, K; };

__device__ __forceinline__ unsigned cvt_pk_bf16(float lo, float hi) { unsigned r; asm volatile("s_nop 0\n\tv_cvt_pk_bf16_f32 %0, %1, %2" : "=v"(r) : "v"(lo), "v"(hi)); return r; }
typedef float f32x2 __attribute__((ext_vector_type(2)));
__device__ __forceinline__ f32x2 gelu_pk(f32x2 v) {
    const f32x2 av = __builtin_elementwise_abs(v), d = av * 0.2316418882f + 1.0f;
    f32x2 t; t.x = __builtin_amdgcn_rcpf(d.x); t.y = __builtin_amdgcn_rcpf(d.y);
    f32x2 q = t * 0.5307027145f + (-0.7265760135f); q = q * t + 0.7107068705f; q = q * t + (-0.142248368f); q = q * t + 0.127414796f; q = q * t;
    const f32x2 s = (v * v) * (-0.72134752044f);
    f32x2 e; e.x = __builtin_amdgcn_exp2f(s.x); e.y = __builtin_amdgcn_exp2f(s.y);
    const f32x2 m = v * (q * e), r = v - m;
    f32x2 o; o.x = v.x < 0.f ? m.x : r.x; o.y = v.y < 0.f ? m.y : r.y; return o;
}

template <class Epi, class Sched, bool ALIGN_EPI = false, bool SP2 = false>
__device__ __forceinline__ void gemm_phase(PG8_LAS unsigned char* lds, const Gemm g, const Sched& S, const Epi& E) {
    int tid_ = threadIdx.x; asm volatile("" : "+v"(tid_));
    const int tid = tid_, wid = __builtin_amdgcn_readfirstlane(tid >> 6), lane = tid & 63, wr = wid >> 2, wc = wid & 3, fr = lane & 15, fq = lane >> 4;
    const int K = g.K, nt = K / BK;
    unsigned voffA[2], voffB[2];
#pragma unroll
    for (int i = 0; i < 2; ++i) { int R, C; stage_rc(tid * 16 + i * 8192, R, C); const int Rb = Epi::PERM ? ((R & ~31) + perm32(R & 31)) : R;
        voffA[i] = (unsigned)(R * g.lda + C) * 2u; voffB[i] = (unsigned)(Rb * g.ldb + C) * 2u; }
    const size_t kstep = (size_t)(BK * 2);
    const size_t hstepA = (size_t)HALF * g.lda * 2, hstepB = (size_t)HALF * g.ldb * 2;
    const unsigned ldsw = (unsigned)wid * 1024u;
    const int aoff = lds_byte(wr * 64 + fr, fq * 8), boff = lds_byte(wc * 32 + fr, fq * 8);
#define PG8_SA(b, h) (((b) * 2 + (h)) * HTB)
#define PG8_SB(b, h) ((4 + (b) * 2 + (h)) * HTB)
#define PG8_STAGE(bufoff, gbase, voff) do { _Pragma("unroll") for (int _i = 0; _i < 2; ++_i) \
        __builtin_amdgcn_global_load_lds((const unsigned*)((const char*)(gbase) + (voff)[_i]), (PG8_LAS unsigned*)(lds + (bufoff) + ldsw + _i * 8192), 16, 0, 0); } while (0)
#define PG8_LDA(dst, b, h) do { _Pragma("unroll") for (int m = 0; m < 4; ++m) _Pragma("unroll") for (int k = 0; k < 2; ++k) dst[m][k] = *(const PG8_LAS bf16x8*)(lds + PG8_SA(b, h) + aoff + m * 2048 + k * 1024); } while (0)
#define PG8_LDB(dst, b, h) do { _Pragma("unroll") for (int n = 0; n < 2; ++n) _Pragma("unroll") for (int k = 0; k < 2; ++k) dst[n][k] = *(const PG8_LAS bf16x8*)(lds + PG8_SB(b, h) + boff + n * 2048 + k * 1024); } while (0)
#define PG8_MMA(ai, bj, At, Bt) do { __builtin_amdgcn_s_setprio(1); _Pragma("unroll") for (int m = 0; m < 4; ++m) _Pragma("unroll") for (int n = 0; n < 2; ++n) _Pragma("unroll") for (int k = 0; k < 2; ++k) \
        acc[ai][bj][m][n] = __builtin_amdgcn_mfma_f32_16x16x32_bf16(Bt[n][k], At[m][k], acc[ai][bj][m][n], 0, 0, 0); __builtin_amdgcn_s_setprio(0); } while (0)
#define PG8_WAIT_V(n) asm volatile("s_waitcnt vmcnt(" #n ")" ::: "memory")
#define PG8_WAIT_L(n) asm volatile("s_waitcnt lgkmcnt(" #n ")" ::: "memory")
#define PG8_BAR __builtin_amdgcn_s_barrier()
#define PG8_SCHED __builtin_amdgcn_sched_barrier(0)
    Unit cur, nxt; int ui = 0;
    if (!S.next(0, cur)) return;
    f32x4 acc[2][2][4][2];
#pragma unroll
    for (int a = 0; a < 2; ++a)
#pragma unroll
        for (int b = 0; b < 2; ++b)
#pragma unroll
            for (int m = 0; m < 4; ++m)
#pragma unroll
                for (int n = 0; n < 2; ++n) acc[a][b][m][n] = (f32x4){0.f, 0.f, 0.f, 0.f};
    bf16x8 At[4][2], B0[2][2], B1[2][2];
    const char* cA = (const char*)g.A + cur.aoff; const char* cB = (const char*)g.Bt + cur.boff;
    if constexpr (SP2) {
        PG8_STAGE(PG8_SB(0, 0), cB, voffB); PG8_STAGE(PG8_SB(0, 1), cB + hstepB, voffB); PG8_STAGE(PG8_SA(0, 0), cA, voffA); PG8_STAGE(PG8_SA(0, 1), cA + hstepA, voffA);
        if (wr == 1) PG8_BAR;
        PG8_WAIT_V(2); PG8_BAR;
        PG8_STAGE(PG8_SB(1, 0), cB + kstep, voffB); PG8_STAGE(PG8_SA(1, 0), cA + kstep, voffA); PG8_STAGE(PG8_SB(1, 1), cB + hstepB + kstep, voffB);
        PG8_WAIT_V(6); PG8_BAR;
    } else {
        PG8_STAGE(PG8_SB(0, 0), cB, voffB); PG8_STAGE(PG8_SA(0, 0), cA, voffA); PG8_STAGE(PG8_SB(0, 1), cB + hstepB, voffB); PG8_STAGE(PG8_SA(0, 1), cA + hstepA, voffA);
        if (wr == 1) PG8_BAR;
        PG8_WAIT_V(4); PG8_BAR;
        PG8_STAGE(PG8_SB(1, 0), cB + kstep, voffB); PG8_STAGE(PG8_SA(1, 0), cA + kstep, voffA); PG8_STAGE(PG8_SB(1, 1), cB + hstepB + kstep, voffB);
        PG8_WAIT_V(6); PG8_BAR;
    }
    for (;;) {
        const bool has_next = S.next(ui + 1, nxt);
        const char* nA = has_next ? (const char*)g.A + nxt.aoff : cA; const char* nB = has_next ? (const char*)g.Bt + nxt.boff : cB;
        for (int t = 0; t < nt; t += 2) {
            const bool last = (t == nt - 2);
            const char* a1 = cA + (size_t)(t + 1) * kstep;
            const char* a2 = last ? nA : cA + (size_t)(t + 2) * kstep; const char* b2 = last ? nB : cB + (size_t)(t + 2) * kstep;
            const char* a3 = a2 + kstep; const char* b3 = b2 + kstep;
            if constexpr (SP2) {
            PG8_LDB(B0, 0, 0); PG8_LDB(B1, 0, 1); PG8_SCHED; PG8_LDA(At, 0, 0); PG8_STAGE(PG8_SA(1, 1), a1 + hstepA, voffA);
            PG8_WAIT_V(8); PG8_WAIT_L(0); PG8_BAR; PG8_MMA(0, 0, At, B0); PG8_MMA(0, 1, At, B1); PG8_BAR; PG8_SCHED;
            PG8_LDA(At, 0, 1); PG8_STAGE(PG8_SB(0, 0), b2, voffB); PG8_STAGE(PG8_SB(0, 1), b2 + hstepB, voffB); PG8_STAGE(PG8_SA(0, 0), a2, voffA);
            PG8_WAIT_V(8); PG8_WAIT_L(0); PG8_BAR; PG8_MMA(1, 0, At, B0); PG8_MMA(1, 1, At, B1); PG8_BAR; PG8_SCHED;
            PG8_LDB(B0, 1, 0); PG8_LDB(B1, 1, 1); PG8_SCHED; PG8_LDA(At, 1, 0); PG8_STAGE(PG8_SA(0, 1), a2 + hstepA, voffA);
            PG8_WAIT_V(8); PG8_WAIT_L(0); PG8_BAR; PG8_MMA(0, 0, At, B0); PG8_MMA(0, 1, At, B1); PG8_BAR; PG8_SCHED;
            PG8_LDA(At, 1, 1); PG8_STAGE(PG8_SB(1, 0), b3, voffB); PG8_STAGE(PG8_SB(1, 1), b3 + hstepB, voffB); PG8_STAGE(PG8_SA(1, 0), a3, voffA);
            PG8_WAIT_V(8); PG8_WAIT_L(0); PG8_BAR; PG8_MMA(1, 0, At, B0); PG8_MMA(1, 1, At, B1); PG8_BAR; PG8_SCHED;
            } else {
            PG8_LDB(B0, 0, 0); PG8_SCHED; PG8_LDA(At, 0, 0); PG8_STAGE(PG8_SA(1, 1), a1 + hstepA, voffA);
            PG8_WAIT_L(8); PG8_BAR; PG8_WAIT_L(0); PG8_MMA(0, 0, At, B0); PG8_BAR; PG8_SCHED;
            PG8_LDB(B1, 0, 1); PG8_STAGE(PG8_SB(0, 0), b2, voffB);
            PG8_BAR; PG8_WAIT_L(0); PG8_MMA(0, 1, At, B1); PG8_BAR;
            PG8_LDA(At, 0, 1); PG8_STAGE(PG8_SA(0, 0), a2, voffA);
            PG8_BAR; PG8_WAIT_L(0); PG8_MMA(1, 0, At, B0); PG8_BAR; PG8_SCHED;
            PG8_STAGE(PG8_SB(0, 1), b2 + hstepB, voffB);
            PG8_WAIT_V(6); PG8_BAR; PG8_MMA(1, 1, At, B1); PG8_BAR;
            PG8_LDB(B0, 1, 0); PG8_SCHED; PG8_LDA(At, 1, 0); PG8_STAGE(PG8_SA(0, 1), a2 + hstepA, voffA);
            PG8_WAIT_L(8); PG8_BAR; PG8_WAIT_L(0); PG8_MMA(0, 0, At, B0); PG8_BAR; PG8_SCHED;
            PG8_LDB(B1, 1, 1); PG8_STAGE(PG8_SB(1, 0), b3, voffB);
            PG8_BAR; PG8_WAIT_L(0); PG8_MMA(0, 1, At, B1); PG8_BAR;
            PG8_LDA(At, 1, 1); PG8_STAGE(PG8_SA(1, 0), a3, voffA);
            PG8_BAR; PG8_WAIT_L(0); PG8_MMA(1, 0, At, B0); PG8_BAR; PG8_SCHED;
            PG8_STAGE(PG8_SB(1, 1), b3 + hstepB, voffB);
            PG8_WAIT_V(6); PG8_BAR; PG8_MMA(1, 1, At, B1); PG8_BAR;
            }
        }
        if constexpr (ALIGN_EPI) { if (wr == 0) PG8_BAR; }
        E(acc, cur, wr, wc, fr, fq);
        if (!has_next) break;
        if (E.zero_after(cur)) {
#pragma unroll
        for (int a = 0; a < 2; ++a)
#pragma unroll
            for (int b = 0; b < 2; ++b)
#pragma unroll
                for (int m = 0; m < 4; ++m)
#pragma unroll
                    for (int n = 0; n < 2; ++n) acc[a][b][m][n] = (f32x4){0.f, 0.f, 0.f, 0.f};
        }
        cur = nxt; cA = nA; cB = nB; ++ui;
        if constexpr (ALIGN_EPI) { if (wr == 1) PG8_BAR; }
    }
    PG8_WAIT_V(0);
    if constexpr (!ALIGN_EPI) { if (wr == 0) PG8_BAR; }
    PG8_BAR;
#undef PG8_SA
#undef PG8_SB
#undef PG8_STAGE
#undef PG8_LDA
#undef PG8_LDB
#undef PG8_MMA
#undef PG8_WAIT_V
#undef PG8_WAIT_L
#undef PG8_BAR
#undef PG8_SCHED
}

__device__ __forceinline__ void tile_map(int L, int nM, int nN, int& pm, int& pn) {
    const int nwg = nM * nN; int wgid = L;
    { const int q = nwg / NXCD, r = nwg % NXCD, xcd = wgid % NXCD, off = wgid / NXCD; wgid = (xcd < r ? xcd * (q + 1) : r * (q + 1) + (xcd - r) * q) + off; }
    const int nig = WGM * nN, gid = wgid / nig, fm = gid * WGM, gsz = (nM - fm) < WGM ? (nM - fm) : WGM;
    pm = fm + ((wgid % nig) % gsz); pn = (wgid % nig) / gsz;
}
struct SchedPlain {
    int nM, nN, G, c; size_t astride, bstride;
    __device__ __forceinline__ bool next(int i, Unit& u) const {
        const long L = (long)i * G + c; if (L >= (long)nM * nN) return false;
        tile_map((int)L, nM, nN, u.pm, u.pn); u.sub = 0; u.aoff = (size_t)u.pm * astride; u.boff = (size_t)u.pn * bstride; return true;
    }
};
struct SchedBranch {
    int nM, nN, G, c;
    __device__ __forceinline__ bool next(int i, Unit& u) const {
        const int t = i / 3, s = i - 3 * t; const long L = (long)t * G + c; if (L >= (long)nM * nN) return false;
        tile_map((int)L, nM, nN, u.pm, u.pn); u.sub = s;
        u.aoff = (size_t)u.pm * (256 * 1536 * 2) + (size_t)s * (512 * 2); u.boff = ((size_t)s * 1024 + (size_t)u.pn * 256) * (512 * 2); return true;
    }
};

__device__ __forceinline__ float row_rstd(const float* slots, int row) {
    const f32x4* sp = (const f32x4*)(slots + (size_t)row * 16);
    const f32x4 s = (sp[0] + sp[1]) + (sp[2] + sp[3]);
    return rsqrtf(((s[0] + s[1]) + (s[2] + s[3])) * (1.0f / 1024.0f) + 1e-6f);
}
__device__ __forceinline__ float sigmoid_c(float z) { z = fminf(fmaxf(z, -30.f), 30.f); return __builtin_amdgcn_rcpf(1.0f + __expf(-z)); }

struct EpiAct {
    static constexpr bool PERM = true, AFTER_DRAIN = false;
    bf16_t* O; int ldc; const float* slots; int mode; PG8_LAS float* R;
    __device__ __forceinline__ bool zero_after(const Unit&) const { return true; }
    __device__ __forceinline__ void operator()(f32x4 (&acc)[2][2][4][2], const Unit& u, int wr, int wc, int fr_, int fq_) const {
        int fr = fr_, fq = fq_; asm volatile("" : "+v"(fr), "+v"(fq));
        { const int tl = (wr * 4 + wc) * 64 + fq * 16 + fr; if (tl < 256) R[tl] = row_rstd(slots, u.pm * BM + tl); }
        asm volatile("s_waitcnt vmcnt(0) lgkmcnt(0)" ::: "memory"); __builtin_amdgcn_s_barrier(); asm volatile("" ::: "memory");
        const int row0 = u.pm * BM + wr * 64 + fr, col0 = u.pn * BM + wc * 32 + 8 * fq;
        const int act = (mode == 1) ? 2 : ((mode == 0 && u.pn < 4) ? 1 : 0);
#pragma unroll
        for (int ai = 0; ai < 2; ++ai)
#pragma unroll
            for (int m = 0; m < 4; ++m) {
                const int row = row0 + ai * HALF + m * 16; const float rs = R[ai * HALF + wr * 64 + m * 16 + fr];
                bf16_t* rowp = O + (size_t)row * ldc + col0;
#pragma unroll
                for (int bj = 0; bj < 2; ++bj) {
                    f32x4 v0 = acc[ai][bj][m][0] * rs, v1 = acc[ai][bj][m][1] * rs;
                    if (act == 1) { f32x2 a = gelu_pk((f32x2){v0[0], v0[1]}), b = gelu_pk((f32x2){v0[2], v0[3]}), c = gelu_pk((f32x2){v1[0], v1[1]}), d = gelu_pk((f32x2){v1[2], v1[3]});
                        v0 = (f32x4){a.x, a.y, b.x, b.y}; v1 = (f32x4){c.x, c.y, d.x, d.y}; }
                    else if (act == 2) { v0 = (f32x4){sigmoid_c(v0[0]), sigmoid_c(v0[1]), sigmoid_c(v0[2]), sigmoid_c(v0[3])}; v1 = (f32x4){sigmoid_c(v1[0]), sigmoid_c(v1[1]), sigmoid_c(v1[2]), sigmoid_c(v1[3])}; }
                    u32x4 w; w.x = cvt_pk_bf16(v0[0], v0[1]); w.y = cvt_pk_bf16(v0[2], v0[3]); w.z = cvt_pk_bf16(v1[0], v1[1]); w.w = cvt_pk_bf16(v1[2], v1[3]);
                    *(u32x4*)(rowp + bj * HALF) = w; }
            }
    }
};
__device__ __forceinline__ void unpack8(const u32x4 v, float (&f)[8]) {
    f[0] = __uint_as_float(v.x << 16); f[1] = __uint_as_float(v.x & 0xffff0000u); f[2] = __uint_as_float(v.y << 16); f[3] = __uint_as_float(v.y & 0xffff0000u);
    f[4] = __uint_as_float(v.z << 16); f[5] = __uint_as_float(v.z & 0xffff0000u); f[6] = __uint_as_float(v.w << 16); f[7] = __uint_as_float(v.w & 0xffff0000u);
}
struct EpiGate {
    static constexpr bool PERM = true, AFTER_DRAIN = false;
    const bf16_t* Gt; bf16_t* O;
    __device__ __forceinline__ bool zero_after(const Unit& u) const { return u.sub == 2; }
    __device__ __forceinline__ void operator()(f32x4 (&acc)[2][2][4][2], const Unit& u, int wr, int wc, int fr_, int fq_) const {
        int fr = fr_, fq = fq_; asm volatile("" : "+v"(fr), "+v"(fq));
        const int row0 = u.pm * BM + wr * 64 + fr, col0 = u.pn * BM + wc * 32 + 8 * fq; const int s = u.sub;
        u32x4 ga[2][2], gb[2][2];
#define GATE_LOAD(st, g) do { const bf16_t* gp_ = Gt + (size_t)(row0 + ((g) >> 2) * HALF + ((g) & 3) * 16) * 3072 + s * 1024 + col0; \
            ga[st][0] = *(const u32x4*)(gp_); ga[st][1] = *(const u32x4*)(gp_ + HALF); \
            if (s < 2) { gb[st][0] = *(const u32x4*)(gp_ + 1024); gb[st][1] = *(const u32x4*)(gp_ + 1024 + HALF); } else { gb[st][0] = ga[st][0]; gb[st][1] = ga[st][1]; } } while (0)
        GATE_LOAD(0, 0);
#pragma unroll
        for (int g = 0; g < 8; ++g) {
            const int ai = g >> 2, m = g & 3, st = g & 1;
            if (g + 1 < 8) GATE_LOAD(st ^ 1, g + 1);
            __builtin_amdgcn_sched_barrier(0);
            const int row = row0 + ai * HALF + m * 16;
#pragma unroll
            for (int bj = 0; bj < 2; ++bj) {
                const int col = col0 + bj * HALF;
                float f[8]; unpack8(ga[st][bj], f);
                if (s < 2) { float h[8]; unpack8(gb[st][bj], h);
#pragma unroll
                    for (int e = 0; e < 8; ++e) f[e] *= __builtin_amdgcn_rcpf(h[e]); }
                f32x4 v0 = acc[ai][bj][m][0], v1 = acc[ai][bj][m][1];
                v0 = v0 * (f32x4){f[0], f[1], f[2], f[3]}; v1 = v1 * (f32x4){f[4], f[5], f[6], f[7]};
                acc[ai][bj][m][0] = v0; acc[ai][bj][m][1] = v1;
                if (s == 2) { u32x4 w; w.x = cvt_pk_bf16(v0[0], v0[1]); w.y = cvt_pk_bf16(v0[2], v0[3]); w.z = cvt_pk_bf16(v1[0], v1[1]); w.w = cvt_pk_bf16(v1[2], v1[3]);
                    *(u32x4*)(O + (size_t)row * 1024 + col) = w; }
            }
            __builtin_amdgcn_sched_barrier(0);
        }
#undef GATE_LOAD
        __builtin_amdgcn_s_waitcnt(0x0F70);
    }
};
struct EpiRes {
    static constexpr bool PERM = false, AFTER_DRAIN = false;
    const float* Xin; float* Xout; bf16_t* XB; float* slots;
    __device__ __forceinline__ bool zero_after(const Unit&) const { return true; }
    __device__ __forceinline__ void operator()(f32x4 (&acc)[2][2][4][2], const Unit& u, int wr, int wc, int fr_, int fq_) const {
        int fr = fr_, fq = fq_; asm volatile("" : "+v"(fr), "+v"(fq));
        const int row0 = u.pm * BM + wr * 64 + fr, col0 = u.pn * BM + wc * 32 + 4 * fq;
        f32x4 xs[2][4];
#define RES_LOAD(st, g) do { const float* p_ = Xin + (size_t)(row0 + ((g) >> 2) * HALF + ((g) & 3) * 16) * 1024 + col0; \
            xs[st][0] = *(const f32x4*)(p_); xs[st][1] = *(const f32x4*)(p_ + 16); xs[st][2] = *(const f32x4*)(p_ + HALF); xs[st][3] = *(const f32x4*)(p_ + HALF + 16); } while (0)
        RES_LOAD(0, 0);
#pragma unroll
        for (int g = 0; g < 8; ++g) {
            const int ai = g >> 2, m = g & 3, st = g & 1;
            if (g + 1 < 8) RES_LOAD(st ^ 1, g + 1);
            __builtin_amdgcn_sched_barrier(0);
            const int row = row0 + ai * HALF + m * 16; const size_t off = (size_t)row * 1024 + col0; float ss = 0.f;
#pragma unroll
            for (int bj = 0; bj < 2; ++bj)
#pragma unroll
                for (int n = 0; n < 2; ++n) {
                    const f32x4 xn = xs[st][bj * 2 + n] + acc[ai][bj][m][n];
                    *(f32x4*)(Xout + off + bj * HALF + n * 16) = xn;
                    ss += (xn[0] * xn[0] + xn[1] * xn[1]) + (xn[2] * xn[2] + xn[3] * xn[3]);
                    u32x2 w; w.x = cvt_pk_bf16(xn[0], xn[1]); w.y = cvt_pk_bf16(xn[2], xn[3]);
                    *(u32x2*)(XB + off + bj * HALF + n * 16) = w; }
            ss += __shfl_xor(ss, 16); ss += __shfl_xor(ss, 32);
            if (fq == 0) slots[(size_t)row * 16 + u.pn * 4 + wc] = ss;
            __builtin_amdgcn_sched_barrier(0);
        }
#undef RES_LOAD
    }
};
struct SchedConv {
    int G, c;
    __device__ __forceinline__ bool next(int i, Unit& u) const {
        const long L = (long)i * G + c; if (L >= 65L * 22L) return false;
        tile_map((int)L, 65, 22, u.pm, u.pn); u.sub = 0;
        u.aoff = (size_t)((long)(254 * u.pm - 2) * 2048L); u.boff = (size_t)u.pn * (256 * 1024 * 2); return true;
    }
};
__device__ __forceinline__ float dpp_f(float oldv, float src, const int ctrl_sel) {
    const int o = __float_as_int(oldv), v = __float_as_int(src);
    return __int_as_float(ctrl_sel == 1 ? __builtin_amdgcn_update_dpp(o, v, 0x111, 0xf, 0xf, false) : __builtin_amdgcn_update_dpp(o, v, 0x112, 0xf, 0xf, false));
}
__device__ __forceinline__ float ror_f(float src, const int n) {
    const int v = __float_as_int(src);
    return __int_as_float(n == 1 ? __builtin_amdgcn_mov_dpp(v, 0x121, 0xf, 0xf, false) : __builtin_amdgcn_mov_dpp(v, 0x122, 0xf, 0xf, false));
}
struct EpiConv {
    static constexpr bool PERM = true, AFTER_DRAIN = false;
    bf16_t* ACT; const float* slots; const float* cw; PG8_LAS float* H;
    __device__ __forceinline__ bool zero_after(const Unit&) const { return true; }
    __device__ __forceinline__ void operator()(f32x4 (&acc)[2][2][4][2], const Unit& u, int wr, int wc, int fr_, int fq_) const {
        int fr = fr_, fq = fq_; asm volatile("" : "+v"(fr), "+v"(fq));
        const int arow0 = 254 * u.pm - 2, cl = wc * 32 + 8 * fq;
        PG8_LAS float* R = H + 3 * 2 * 256;
        PG8_LAS float* CWl = R + 256;
        { const int tl = (wr * 4 + wc) * 64 + fq * 16 + fr;
          if (tl < 256) { int row = arow0 + tl; row = row < 0 ? 0 : (row > 16383 ? 16383 : row); R[tl] = row_rstd(slots, row); }
          else if (tl < 448) { const int k = (tl - 256) >> 6, col = ((tl - 256) & 63) * 4; *(PG8_LAS f32x4*)(CWl + k * 256 + col) = *(const f32x4*)(cw + k * 5632 + (col < 128 ? 128 * u.pn + col : 2816 + 128 * u.pn + col - 128)); } }
#pragma unroll
        for (int ai = 0; ai < 2; ++ai) { const int s = 2 * ai + wr;
            if (s < 3 && fr >= 14) {
#pragma unroll
                for (int bj = 0; bj < 2; ++bj)
#pragma unroll
                    for (int n = 0; n < 2; ++n) *(PG8_LAS f32x4*)(H + (s * 2 + (fr - 14)) * 256 + bj * HALF + cl + 4 * n) = acc[ai][bj][3][n]; } }
        asm volatile("s_waitcnt vmcnt(0) lgkmcnt(0)" ::: "memory"); __builtin_amdgcn_s_barrier(); asm volatile("" ::: "memory");
#pragma unroll
        for (int ai = 0; ai < 2; ++ai)
#pragma unroll
            for (int m = 0; m < 4; ++m) { const float rs = R[ai * HALF + wr * 64 + m * 16 + fr];
#pragma unroll
                for (int bj = 0; bj < 2; ++bj) { acc[ai][bj][m][0] = acc[ai][bj][m][0] * rs; acc[ai][bj][m][1] = acc[ai][bj][m][1] * rs; } }
        const int tbg = (arow0 + wr * 64) & 8191; const bool gedge = (tbg >= 8177) || (tbg <= 1);
#pragma unroll
        for (int n = 0; n < 2; ++n) {
            f32x4 wg[3], wv[3];
#pragma unroll
            for (int k = 0; k < 3; ++k) { wg[k] = *(const PG8_LAS f32x4*)(CWl + k * 256 + cl + 4 * n); wv[k] = *(const PG8_LAS f32x4*)(CWl + k * 256 + 128 + cl + 4 * n); }
#pragma unroll
            for (int ai = 0; ai < 2; ++ai) {
                const int s = 2 * ai + wr;
                f32x4 h1[2], h2[2];
#pragma unroll
                for (int bj = 0; bj < 2; ++bj) {
                    if (s > 0) { h1[bj] = *(const PG8_LAS f32x4*)(H + ((s - 1) * 2 + 1) * 256 + bj * HALF + cl + 4 * n) * R[64 * s - 1]; h2[bj] = *(const PG8_LAS f32x4*)(H + ((s - 1) * 2 + 0) * 256 + bj * HALF + cl + 4 * n) * R[64 * s - 2]; }
                    else { h1[bj] = (f32x4){0.f, 0.f, 0.f, 0.f}; h2[bj] = (f32x4){0.f, 0.f, 0.f, 0.f}; } }
#pragma unroll
                for (int m = 0; m < 4; ++m) {
                    const int lr = ai * HALF + wr * 64 + m * 16 + fr, t = arow0 + lr, tb = t & 8191;
                    const bool k1 = tb >= 1, k2 = tb >= 2;
                    float o[4];
#pragma unroll
                    for (int jj = 0; jj < 4; ++jj) {
                        float cv[2];
#pragma unroll
                        for (int bj = 0; bj < 2; ++bj) {
                            const float cur = acc[ai][bj][m][n][jj];
                            float o1, o2;
                            if (m > 0) { const float prv = acc[ai][bj][m - 1][n][jj]; o1 = ror_f(prv, 1); o2 = ror_f(prv, 2); }
                            else { o1 = h1[bj][jj]; o2 = (fr == 0) ? h2[bj][jj] : o1; }
                            float x1 = dpp_f(o1, cur, 1), x2 = dpp_f(o2, cur, 2);
                            if (ai == 0 && m == 0) { x1 = (gedge && !k1) ? 0.f : x1; x2 = (gedge && !k2) ? 0.f : x2; }
                            cv[bj] = bj == 0 ? (wg[0][jj] * x2 + wg[1][jj] * x1 + wg[2][jj] * cur) : (wv[0][jj] * x2 + wv[1][jj] * x1 + wv[2][jj] * cur);
                        }
                        o[jj] = cv[0] * __builtin_amdgcn_rcpf(1.0f + __expf(-cv[0])) * cv[1];
                    }
                    u32x2 pk; pk.x = cvt_pk_bf16(o[0], o[1]); pk.y = cvt_pk_bf16(o[2], o[3]);
                    if (lr >= 2 && t < 16384) *(u32x2*)(ACT + (size_t)t * 2816 + 128 * u.pn + cl + 4 * n) = pk;
                    asm volatile("" ::: "memory");
                }
            }
        }
    }
};
}

#define LAS __attribute__((address_space(3)))
typedef pg8::bf16_t bf16;
typedef pg8::f32x4 f32x4;
typedef pg8::u32x4 u32x4;
typedef pg8::u32x2 u32x2;
typedef pg8::bf16x8 bf16x8;
constexpr int DM = 1024, SEQ = 8192, M = 16384, DEPTH = 2, INC = 6144, DFF = 2816, UPC = 5632;
constexpr size_t MiB = 1u << 20;
constexpr size_t WS_BAR = 16384;
constexpr size_t WS_SLOTS = 1 * MiB;
constexpr size_t WS_WIN = 2 * MiB, WS_WBR = 14 * MiB, WS_WO = 17 * MiB, WS_WUP = 19 * MiB, WS_WDN = 30 * MiB;
constexpr size_t WS_XB = 36 * MiB;
constexpr size_t WS_PA = 68 * MiB;
constexpr size_t WS_Y = 164 * MiB;
constexpr size_t WS_MG = 212 * MiB;
constexpr size_t WS_AP = 68 * MiB;
constexpr size_t WS_ACT = 156 * MiB;
constexpr size_t WS_WUP1 = 244 * MiB, WS_WDN1 = 19 * MiB;
constexpr size_t WS_END = 255 * MiB;
constexpr int LDS_BYTES = 143360, LDS_ST = 143360 - 64;

struct Args { const float* in[18]; float* out; unsigned char* ws; };
enum { I_X = 0, I_NMIX, I_WIN, I_SLN, I_SW, I_SB, I_CBW, I_PW, I_PS, I_WA, I_WB, I_WC, I_WO, I_NFFN, I_WUP, I_FCW, I_WDN, I_NF };

__device__ __forceinline__ int tid_l() { int t = threadIdx.x; asm volatile("" : "+v"(t)); return t; }
__device__ __forceinline__ float wave_sum(float v) {
#pragma unroll
    for (int o = 1; o < 64; o <<= 1) v += __shfl_xor(v, o);
    return v;
}
__device__ __forceinline__ unsigned pk2(float lo, float hi) { return pg8::cvt_pk_bf16(lo, hi); }
__device__ __forceinline__ float bf_lo(unsigned w) { return __uint_as_float(w << 16); }
__device__ __forceinline__ float bf_hi(unsigned w) { return __uint_as_float(w & 0xffff0000u); }

struct TrItem { const float* W; bf16* WT; const float* ksc; int K, N, dst_row0, k0, n0; };
__device__ __forceinline__ void tr_load(const TrItem& t, f32x4 (&v)[16], int lane) {
    const int r = lane >> 4, c4 = (lane & 15) * 4;
#pragma unroll
    for (int i = 0; i < 16; ++i) v[i] = *(const f32x4*)(t.W + (size_t)(t.k0 + 4 * i + r) * t.N + t.n0 + c4);
}
__device__ __forceinline__ void tr_store(const TrItem& t, const f32x4 (&v)[16], LAS float* scr, int lane) {
    const int r = lane >> 4, c4 = (lane & 15) * 4;
#pragma unroll
    for (int i = 0; i < 16; ++i) { const float sc = t.ksc ? t.ksc[t.k0 + 4 * i + r] : 1.0f; LAS float* d = scr + (4 * i + r) * 65 + c4; d[0] = v[i][0] * sc; d[1] = v[i][1] * sc; d[2] = v[i][2] * sc; d[3] = v[i][3] * sc; }
    asm volatile("s_waitcnt lgkmcnt(0)" ::: "memory");
    const int c = lane & 7;
#pragma unroll
    for (int j = 0; j < 8; ++j) { const int n = (lane >> 3) + 8 * j; const LAS float* s = scr + (8 * c) * 65 + n;
        u32x4 o; o.x = pk2(s[0 * 65], s[1 * 65]); o.y = pk2(s[2 * 65], s[3 * 65]); o.z = pk2(s[4 * 65], s[5 * 65]); o.w = pk2(s[6 * 65], s[7 * 65]);
        *(u32x4*)(t.WT + (size_t)(t.dst_row0 + n) * t.K + t.k0 + 8 * c) = o; }
    asm volatile("s_waitcnt lgkmcnt(0)" ::: "memory");
}
constexpr int CI_IN = (DM / 64) * (INC / 64), CI_BR = (512 / 64) * (DM / 64), CI_O = (DM / 64) * (DM / 64), CI_UP = (DM / 64) * (UPC / 64), CI_DN = (DFF / 64) * (DM / 64);
constexpr int CI_A = CI_IN + 3 * CI_BR + CI_O, CI_B = CI_A + CI_UP, CI_ALL = CI_B + CI_DN;
__device__ __forceinline__ TrItem tr_decode(const Args& a, int l, int it) {
    unsigned char* ws = a.ws; TrItem t; int r = it;
    if (r < CI_IN) { const int nblk = INC / 64, kb = r / nblk, nb = r % nblk; t.W = a.in[I_WIN] + (size_t)l * DM * INC; t.K = DM; t.N = INC; t.WT = (bf16*)(ws + WS_WIN); t.dst_row0 = 64 * nb; t.ksc = a.in[I_NMIX] + l * DM; t.k0 = 64 * kb; t.n0 = 64 * nb; return t; } r -= CI_IN;
    if (r < 3 * CI_BR) { const int br = r / CI_BR; r -= br * CI_BR; const int nblk = DM / 64, kb = r / nblk, nb = r % nblk;
        t.W = a.in[I_WA + br] + (size_t)l * 512 * DM; t.K = 512; t.N = DM; t.WT = (bf16*)(ws + WS_WBR); t.dst_row0 = br * 1024 + 64 * nb; t.ksc = nullptr; t.k0 = 64 * kb; t.n0 = 64 * nb; return t; } r -= 3 * CI_BR;
    if (r < CI_O) { const int nblk = DM / 64, kb = r / nblk, nb = r % nblk; t.W = a.in[I_WO] + (size_t)l * DM * DM; t.K = DM; t.N = DM; t.WT = (bf16*)(ws + WS_WO); t.dst_row0 = 64 * nb; t.ksc = nullptr; t.k0 = 64 * kb; t.n0 = 64 * nb; return t; } r -= CI_O;
    if (r < CI_UP) { const int nblk = UPC / 64, kb = r / nblk, nb = r % nblk; const int n0 = 64 * nb; const int j = n0 < DFF ? n0 : n0 - DFF;
        t.W = a.in[I_WUP] + (size_t)l * DM * UPC; t.K = DM; t.N = UPC; t.WT = (bf16*)(ws + (l == 0 ? WS_WUP : WS_WUP1)); t.dst_row0 = 256 * (j / 128) + (j % 128) + (n0 < DFF ? 0 : 128); t.ksc = a.in[I_NFFN] + l * DM; t.k0 = 64 * kb; t.n0 = n0; return t; } r -= CI_UP;
    { const int nblk = DM / 64, kb = r / nblk, nb = r % nblk; t.W = a.in[I_WDN] + (size_t)l * DFF * DM; t.K = DFF; t.N = DM; t.WT = (bf16*)(ws + (l == 0 ? WS_WDN : WS_WDN1)); t.dst_row0 = 64 * nb; t.ksc = nullptr; t.k0 = 64 * kb; t.n0 = 64 * nb; return t; }
}
__device__ __forceinline__ void convert_items(LAS unsigned char* lds, const Args& a, int l, int it_lo, int it_hi, int wk, int nwk) {
    const int tidl = tid_l(), lane = tidl & 63, wave = tidl >> 6;
    LAS float* scr = (LAS float*)(lds + wave * 16640);
    int it = it_lo + wk; if (it >= it_hi) return;
    TrItem cur = tr_decode(a, l, it); f32x4 v[16]; tr_load(cur, v, lane);
    for (;;) {
        const int itn = it + nwk; const bool more = itn < it_hi;
        f32x4 w[16]; TrItem nxt = cur;
        if (more) { nxt = tr_decode(a, l, itn); tr_load(nxt, w, lane); }
        tr_store(cur, v, scr, lane);
        if (!more) break;
#pragma unroll
        for (int i = 0; i < 16; ++i) v[i] = w[i];
        cur = nxt; it = itn;
    }
}
__device__ __forceinline__ void xprep_phase(const Args& a) {
    const int tidl = tid_l(), lane = tidl & 63, wave = tidl >> 6;
    const int gw = blockIdx.x * 8 + wave, NGW = gridDim.x * 8;
    unsigned char* ws = a.ws;
    {
        const float* x = a.in[I_X]; bf16* xb = (bf16*)(ws + WS_XB); float* slots = (float*)(ws + WS_SLOTS);
        for (int m = gw; m < M; m += NGW) {
            const f32x4* xr = (const f32x4*)(x + (size_t)m * DM) + lane; f32x4 v[4]; float s = 0.f;
#pragma unroll
            for (int j = 0; j < 4; ++j) { v[j] = xr[64 * j]; s += (v[j][0] * v[j][0] + v[j][1] * v[j][1]) + (v[j][2] * v[j][2] + v[j][3] * v[j][3]); }
            s = wave_sum(s);
            u32x2* o8 = (u32x2*)(xb + (size_t)m * DM) + lane;
#pragma unroll
            for (int j = 0; j < 4; ++j) { u32x2 w; w.x = pk2(v[j][0], v[j][1]); w.y = pk2(v[j][2], v[j][3]); o8[64 * j] = w; }
            if (lane < 4) { f32x4 z = (f32x4){0.f, 0.f, 0.f, 0.f}; if (lane == 0) z[0] = s; ((f32x4*)(slots + (size_t)m * 16))[lane] = z; }
        }
    }
}

#define LDS_BAR() asm volatile("s_waitcnt lgkmcnt(0)\n\ts_barrier" ::: "memory")
__device__ __forceinline__ void mixer_phase(LAS unsigned char* lds, const Args& a, int l) {
    const int tid = tid_l(), lane = tid & 63, wid = tid >> 6, r16 = lane & 15, q = lane >> 4;
    LAS bf16* Wl = (LAS bf16*)lds;
    LAS bf16* Tl = (LAS bf16*)(lds + 34816);
    LAS float* Fl = (LAS float*)(lds + 69632);
    LAS bf16* Zl = (LAS bf16*)(lds + 70656);
    const bf16* PA = (const bf16*)(a.ws + WS_PA); bf16* Y = (bf16*)(a.ws + WS_Y);
    int cur_job = -1; bool have = false;
    u32x4 pf[5];
#pragma unroll
    for (int k = 0; k < 5; ++k) pf[k] = (u32x4){0u, 0u, 0u, 0u};
    const bool split = (gridDim.x == 256); const int cb = blockIdx.x;
    int sj = 0, srank = 0, sn = 1;
    if (split) { if (cb < 104) { sj = cb / 13; srank = cb % 13; sn = 13; } else if (cb < 168) { sj = 8 + (cb - 104) / 16; srank = (cb - 104) % 16; sn = 16; } else { sj = 12 + (cb - 168) / 22; srank = (cb - 168) % 22; sn = 22; } }
    for (int it = 0;; ++it) {
        int job, blk, jobn, blkn; bool okn;
        if (split) { blk = srank + it * sn; if (blk >= 128) break; job = sj; blkn = blk + sn; okn = blkn < 128; jobn = sj; }
        else { const int u = cb + it * (int)gridDim.x; if (u >= 2048) break; job = u & 15; blk = u >> 4; const int un = u + (int)gridDim.x; okn = un < 2048; jobn = un & 15; blkn = un >> 4; }
        const int R0 = blk * 128; const bool pre = okn && (jobn == job); const int R0n = blkn * 128;
        if (job != cur_job) {
            __syncthreads();
            if (job < 8) {
                const float* W = a.in[I_SW] + (size_t)(l * 8 + job) * 16384;
                for (int idx = tid; idx < 4096; idx += 512) { const int i = idx >> 5, j0 = (idx & 31) * 4; f32x4 w = *(const f32x4*)(W + i * 128 + j0);
                    if (i < 64 && j0 >= 64) w = (f32x4){0.f, 0.f, 0.f, 0.f};
                    u32x2 o; o.x = pk2(w[0], w[1]); o.y = pk2(w[2], w[3]); *(LAS u32x2*)(Wl + i * 136 + j0) = o; }
                if (tid < 128) Fl[tid] = a.in[I_SB][(l * 8 + job) * 128 + tid];
                else if (tid < 192) Fl[tid] = a.in[I_SLN][l * 512 + job * 64 + (tid - 128)];
            } else if (job >= 12) {
                const int g = job - 12; const float* W = a.in[I_PW] + (size_t)(l * 4 + g) * 16384;
                for (int idx = tid; idx < 4096; idx += 512) { const int c = idx & 127, d0 = (idx >> 7) * 4; const f32x4 w = *(const f32x4*)(W + c * 128 + d0);
#pragma unroll
                    for (int e = 0; e < 4; ++e) Wl[(d0 + e) * 136 + c] = (bf16)(pk2(w[e], 0.f) & 0xffffu); }
                if (tid < 128) Fl[tid] = a.in[I_PS][l * 512 + g * 128 + tid];
            }
            __syncthreads();
            cur_job = job; have = false;
        }
        if (job < 8) {
            const int g = job, vrow = tid >> 2, ch0 = (tid & 3) * 16, ui = 16 * wid + r16;
#define SGU_LOAD(R) do { const u32x4* src_ = (const u32x4*)(PA + (size_t)((R) + vrow) * 3072 + 512 + g * 64 + ch0); pf[0] = src_[0]; pf[1] = src_[1]; \
                const bf16* up_ = PA + (size_t)((R) + 16 * wid + (lane >> 3)) * 3072 + g * 64 + 8 * (lane & 7); pf[2] = *(const u32x4*)(up_); pf[3] = *(const u32x4*)(up_ + 8 * 3072); } while (0)
            if (!have) SGU_LOAD(R0);
            const u32x4 cv0 = pf[0], cv1 = pf[1], cu0 = pf[2], cu1 = pf[3];
            if (pre) SGU_LOAD(R0n);
            have = pre;
#undef SGU_LOAD
            {
                float v[16]; { float t0[8], t1[8]; pg8::unpack8(cv0, t0); pg8::unpack8(cv1, t1);
#pragma unroll
                    for (int e = 0; e < 8; ++e) { v[e] = t0[e]; v[8 + e] = t1[e]; } }
                float s = 0.f;
#pragma unroll
                for (int e = 0; e < 16; ++e) s += v[e];
                s += __shfl_xor(s, 1); s += __shfl_xor(s, 2);
                const float mu = s * (1.0f / 64.0f); float s2 = 0.f;
#pragma unroll
                for (int e = 0; e < 16; ++e) { v[e] -= mu; s2 += v[e] * v[e]; }
                s2 += __shfl_xor(s2, 1); s2 += __shfl_xor(s2, 2);
                const float rstd = rsqrtf(s2 * (1.0f / 64.0f) + 1e-6f);
#pragma unroll
                for (int e = 0; e < 16; ++e) Tl[(ch0 + e) * 136 + vrow] = (bf16)(pk2(v[e] * rstd * Fl[128 + ch0 + e], 0.f) & 0xffffu);
            }
            LDS_BAR();
            f32x4 acc[4];
#pragma unroll
            for (int ct = 0; ct < 4; ++ct) acc[ct] = (f32x4){0.f, 0.f, 0.f, 0.f};
#pragma unroll
            for (int ks = 0; ks < 4; ++ks) {
                const bf16x8 bfr = *(const LAS bf16x8*)(Wl + (16 * wid + r16) * 136 + 32 * ks + 8 * q);
#pragma unroll
                for (int ct = 0; ct < 4; ++ct) { const bf16x8 afr = *(const LAS bf16x8*)(Tl + (16 * ct + r16) * 136 + 32 * ks + 8 * q);
                    acc[ct] = __builtin_amdgcn_mfma_f32_16x16x32_bf16(afr, bfr, acc[ct], 0, 0, 0); }
            }
            {
                LAS float* Sl = (LAS float*)Zl;
                const float bias = Fl[ui];
#pragma unroll
                for (int ct = 0; ct < 4; ++ct) *(LAS f32x4*)(Sl + ui * 68 + 16 * ct + 4 * q) = acc[ct] + bias;
                asm volatile("s_waitcnt lgkmcnt(0)" ::: "memory");
#pragma unroll
                for (int k = 0; k < 2; ++k) { const int i = 16 * wid + (lane >> 3) + 8 * k, c8 = 8 * (lane & 7);
                    const f32x4 s0 = *(const LAS f32x4*)(Sl + i * 68 + c8), s1 = *(const LAS f32x4*)(Sl + i * 68 + c8 + 4);
                    float uf[8]; pg8::unpack8(k == 0 ? cu0 : cu1, uf);
                    u32x4 o; o.x = pk2(uf[0] * s0[0], uf[1] * s0[1]); o.y = pk2(uf[2] * s0[2], uf[3] * s0[3]); o.z = pk2(uf[4] * s1[0], uf[5] * s1[1]); o.w = pk2(uf[6] * s1[2], uf[7] * s1[3]);
                    *(u32x4*)(Y + (size_t)(R0 + i) * 1536 + g * 64 + c8) = o; }
            }
            LDS_BAR();
        } else if (job < 12) {
            const int c0 = 128 * (job - 8) + 8 * (tid & 15), gr0 = R0 + 4 * (tid >> 4), tb0 = gr0 & (SEQ - 1);
            const float* cw = a.in[I_CBW] + (size_t)l * 3 * 512 + c0;
            float w0[8], w1[8], w2[8];
            { const f32x4 a0 = *(const f32x4*)(cw), a1 = *(const f32x4*)(cw + 4), b0 = *(const f32x4*)(cw + 512), b1 = *(const f32x4*)(cw + 516), d0 = *(const f32x4*)(cw + 1024), d1 = *(const f32x4*)(cw + 1028);
#pragma unroll
              for (int e = 0; e < 4; ++e) { w0[e] = a0[e]; w0[4 + e] = a1[e]; w1[e] = b0[e]; w1[4 + e] = b1[e]; w2[e] = d0[e]; w2[4 + e] = d1[e]; } }
            float z2[8], z1[8];
#pragma unroll
            for (int e = 0; e < 8; ++e) { z2[e] = 0.f; z1[e] = 0.f; }
            if (tb0 >= 2) { float cgv[8], xv[8]; const bf16* p = PA + (size_t)(gr0 - 2) * 3072 + c0; pg8::unpack8(*(const u32x4*)(p + 1536), cgv); pg8::unpack8(*(const u32x4*)(p + 2048), xv);
#pragma unroll
                for (int e = 0; e < 8; ++e) z2[e] = cgv[e] * xv[e]; }
            if (tb0 >= 1) { float cgv[8], xv[8]; const bf16* p = PA + (size_t)(gr0 - 1) * 3072 + c0; pg8::unpack8(*(const u32x4*)(p + 1536), cgv); pg8::unpack8(*(const u32x4*)(p + 2048), xv);
#pragma unroll
                for (int e = 0; e < 8; ++e) z1[e] = cgv[e] * xv[e]; }
#pragma unroll
            for (int rr = 0; rr < 4; ++rr) {
                const bf16* p = PA + (size_t)(gr0 + rr) * 3072 + c0; float bgv[8], cgv[8], xv[8], o[8];
                pg8::unpack8(*(const u32x4*)(p + 1024), bgv); pg8::unpack8(*(const u32x4*)(p + 1536), cgv); pg8::unpack8(*(const u32x4*)(p + 2048), xv);
#pragma unroll
                for (int e = 0; e < 8; ++e) { const float z0 = cgv[e] * xv[e]; o[e] = bgv[e] * (w0[e] * z2[e] + w1[e] * z1[e] + w2[e] * z0); z2[e] = z1[e]; z1[e] = z0; }
                u32x4 w; w.x = pk2(o[0], o[1]); w.y = pk2(o[2], o[3]); w.z = pk2(o[4], o[5]); w.w = pk2(o[6], o[7]);
                *(u32x4*)(Y + (size_t)(gr0 + rr) * 1536 + 512 + c0) = w;
            }
        } else {
            const int g = job - 12, win = 2 << g, c0 = 8 * (tid & 15), rl0 = 4 * (tid >> 4), tb0 = (R0 + rl0) & (SEQ - 1);
            const bf16* zc = PA + 2560 + 128 * g;
#define POOL_LOAD(R) do { const int tbb_ = ((R) & (SEQ - 1)) - 15; _Pragma("unroll") for (int k = 0; k < 5; ++k) { const int idx_ = tid + 512 * k, row_ = idx_ >> 4, ch_ = idx_ & 15; \
                pf[k] = (idx_ < 2288 && tbb_ + row_ >= 0) ? *(const u32x4*)(zc + (size_t)((R) - 15 + row_) * 3072 + 8 * ch_) : (u32x4){0u, 0u, 0u, 0u}; } } while (0)
            if (!have) POOL_LOAD(R0);
#pragma unroll
            for (int k = 0; k < 5; ++k) { const int idx = tid + 512 * k, row = idx >> 4, ch = idx & 15; if (idx < 2288) *(LAS u32x4*)(Zl + row * 136 + 8 * ch) = pf[k]; }
            if (pre) POOL_LOAD(R0n);
            have = pre;
#undef POOL_LOAD
            LDS_BAR();
            float S[8];
#pragma unroll
            for (int e = 0; e < 8; ++e) S[e] = 0.f;
#pragma unroll
            for (int d = 15; d >= 1; --d) { if (d < win) { float z[8]; pg8::unpack8(*(const LAS u32x4*)(Zl + (15 + rl0 - d) * 136 + c0), z);
#pragma unroll
                for (int e = 0; e < 8; ++e) S[e] += z[e]; } }
#pragma unroll
            for (int rr = 0; rr < 4; ++rr) {
                float z[8]; pg8::unpack8(*(const LAS u32x4*)(Zl + (15 + rl0 + rr) * 136 + c0), z);
#pragma unroll
                for (int e = 0; e < 8; ++e) S[e] += z[e];
                if (rr > 0) { float zo[8]; pg8::unpack8(*(const LAS u32x4*)(Zl + (15 + rl0 + rr - win) * 136 + c0), zo);
#pragma unroll
                    for (int e = 0; e < 8; ++e) S[e] -= zo[e]; }
                const int tb = tb0 + rr; const float inv = 1.0f / (float)((tb + 1) < win ? (tb + 1) : win); float o[8];
#pragma unroll
                for (int e = 0; e < 8; ++e) o[e] = S[e] * inv - z[e];
                u32x4 w; w.x = pk2(o[0], o[1]); w.y = pk2(o[2], o[3]); w.z = pk2(o[4], o[5]); w.w = pk2(o[6], o[7]);
                *(LAS u32x4*)(Tl + (rl0 + rr) * 136 + c0) = w;
            }
            LDS_BAR();
            f32x4 acc[8];
#pragma unroll
            for (int dt = 0; dt < 8; ++dt) acc[dt] = (f32x4){0.f, 0.f, 0.f, 0.f};
#pragma unroll
            for (int ks = 0; ks < 4; ++ks) {
                const bf16x8 bfr = *(const LAS bf16x8*)(Tl + (16 * wid + r16) * 136 + 32 * ks + 8 * q);
#pragma unroll
                for (int dt = 0; dt < 8; ++dt) { const bf16x8 afr = *(const LAS bf16x8*)(Wl + (16 * dt + r16) * 136 + 32 * ks + 8 * q);
                    acc[dt] = __builtin_amdgcn_mfma_f32_16x16x32_bf16(afr, bfr, acc[dt], 0, 0, 0); }
            }
            {
                const int t = 16 * wid + r16;
#pragma unroll
                for (int dt = 0; dt < 8; ++dt) { const int d0 = 16 * dt + 4 * q; const f32x4 sc = *(const LAS f32x4*)(Fl + d0);
                    u32x2 o; o.x = pk2(acc[dt][0] * sc[0], acc[dt][1] * sc[1]); o.y = pk2(acc[dt][2] * sc[2], acc[dt][3] * sc[3]);
                    *(LAS u32x2*)(Tl + t * 136 + d0) = o; }
                asm volatile("s_waitcnt lgkmcnt(0)" ::: "memory");
#pragma unroll
                for (int k = 0; k < 4; ++k) { const int row = 16 * wid + (lane >> 4) + 4 * k, ch = lane & 15;
                    *(u32x4*)(Y + (size_t)(R0 + row) * 1536 + 1024 + 128 * g + 8 * ch) = *(const LAS u32x4*)(Tl + row * 136 + 8 * ch); }
            }
            LDS_BAR();
        }
    }
}

__device__ __forceinline__ void ffn_conv_phase(const Args& a, int l, int half) {
    const bf16* AP = (const bf16*)(a.ws + WS_AP); bf16* ACT = (bf16*)(a.ws + WS_ACT);
    const int gtid = blockIdx.x * 512 + tid_l(), nth = gridDim.x * 512;
    for (int it = gtid; it < 1024 * 11 * 16; it += nth) {
        const int chg = it & 15, tmp = it >> 4, n = tmp % 11, rc = tmp / 11;
        const int jg = 128 * (n + 11 * half) + 8 * chg, cb = 256 * n + 8 * chg, gr0 = 16 * rc, tb0 = gr0 & (SEQ - 1);
        const float* cw = a.in[I_FCW] + (size_t)l * 3 * UPC + jg;
        float wg[3][8], wv[3][8];
#pragma unroll
        for (int k = 0; k < 3; ++k) { const f32x4 g0 = *(const f32x4*)(cw + k * UPC), g1 = *(const f32x4*)(cw + k * UPC + 4), v0 = *(const f32x4*)(cw + k * UPC + DFF), v1 = *(const f32x4*)(cw + k * UPC + DFF + 4);
#pragma unroll
            for (int e = 0; e < 4; ++e) { wg[k][e] = g0[e]; wg[k][4 + e] = g1[e]; wv[k][e] = v0[e]; wv[k][4 + e] = v1[e]; } }
        float g2[8], g1[8], v2[8], v1[8];
#pragma unroll
        for (int e = 0; e < 8; ++e) { g2[e] = 0.f; g1[e] = 0.f; v2[e] = 0.f; v1[e] = 0.f; }
        if (tb0 >= 2) { const bf16* p = AP + (size_t)(gr0 - 2) * DFF + cb; pg8::unpack8(*(const u32x4*)p, g2); pg8::unpack8(*(const u32x4*)(p + 128), v2); }
        if (tb0 >= 1) { const bf16* p = AP + (size_t)(gr0 - 1) * DFF + cb; pg8::unpack8(*(const u32x4*)p, g1); pg8::unpack8(*(const u32x4*)(p + 128), v1); }
#pragma unroll 4
        for (int rr = 0; rr < 16; ++rr) {
            const bf16* p = AP + (size_t)(gr0 + rr) * DFF + cb; float g0[8], v0[8], o[8];
            pg8::unpack8(*(const u32x4*)p, g0); pg8::unpack8(*(const u32x4*)(p + 128), v0);
#pragma unroll
            for (int e = 0; e < 8; ++e) {
                const float ag = wg[0][e] * g2[e] + wg[1][e] * g1[e] + wg[2][e] * g0[e], av = wv[0][e] * v2[e] + wv[1][e] * v1[e] + wv[2][e] * v0[e];
                o[e] = ag * __builtin_amdgcn_rcpf(1.0f + __expf(-ag)) * av;
                g2[e] = g1[e]; g1[e] = g0[e]; v2[e] = v1[e]; v1[e] = v0[e]; }
            u32x4 w; w.x = pk2(o[0], o[1]); w.y = pk2(o[2], o[3]); w.z = pk2(o[4], o[5]); w.w = pk2(o[6], o[7]);
            *(u32x4*)(ACT + (size_t)(gr0 + rr) * DFF + jg) = w;
        }
    }
}

__device__ __forceinline__ void final_norm(const Args& a) {
    const int tidl = tid_l(), lane = tidl & 63, gw = blockIdx.x * 8 + (tidl >> 6), NGW = gridDim.x * 8;
    const f32x4* gp = (const f32x4*)a.in[I_NF] + lane;
    for (int m = gw; m < M; m += NGW) {
        f32x4* xr = (f32x4*)(a.out + (size_t)m * DM) + lane; f32x4 v[4]; float s = 0.f;
#pragma unroll
        for (int j = 0; j < 4; ++j) { v[j] = xr[64 * j]; s += (v[j][0] * v[j][0] + v[j][1] * v[j][1]) + (v[j][2] * v[j][2] + v[j][3] * v[j][3]); }
        const float rs = rsqrtf(wave_sum(s) * (1.0f / 1024.0f) + 1e-6f);
#pragma unroll
        for (int j = 0; j < 4; ++j) xr[64 * j] = v[j] * rs * gp[64 * j];
    }
}

#define XB_TMO      128
#define XB_XCNT(j)  (256  + 64 * (j))
#define XB_XSUB(j)  (1280 + 64 * (j))
#define XB_XGEN(j)  (2304 + 64 * (j))
#define XB_TOP      3328
#define XB_TOPGEN   3392
#define XCD_BAR_WORDS 3456
#define XB_SPIN_CAP (1u << 18)

__device__ __forceinline__ unsigned xb_ld(unsigned* p)              { return __hip_atomic_load(p, __ATOMIC_RELAXED, __HIP_MEMORY_SCOPE_AGENT); }
__device__ __forceinline__ unsigned xb_add(unsigned* p, unsigned v) { return __hip_atomic_fetch_add(p, v, __ATOMIC_RELAXED, __HIP_MEMORY_SCOPE_AGENT); }
__device__ __forceinline__ unsigned xb_xcc_id() { return (unsigned)__builtin_amdgcn_s_getreg((3 << 11) | 20) & 0xFu; }
#define XB_SPIN(cond, bar) do { unsigned _sp = 0; while (cond) { __builtin_amdgcn_s_sleep(1); \
    if ((++_sp & 255u) == 0u) { if (xb_ld(&(bar)[XB_TMO])) break; if (_sp > XB_SPIN_CAP) { atomicAdd(&(bar)[XB_TMO], 1u); break; } } } } while (0)

struct XcdBarrier {
    unsigned* bar; unsigned x;
    volatile LAS unsigned* st;
};

__device__ __forceinline__ XcdBarrier xcd_barrier_post(unsigned* bar, volatile LAS unsigned* st) {
    XcdBarrier b; b.bar = bar; b.x = xb_xcc_id(); b.st = st;
    if (threadIdx.x == 0) (void)xb_add(&bar[XB_XCNT(b.x)], 1u);
    return b;
}
__device__ __forceinline__ void xcd_barrier_complete(unsigned* bar, unsigned x, unsigned& nloc, unsigned& nx) {
    const unsigned G = gridDim.x * gridDim.y * gridDim.z;
    unsigned sum, cnt, mine, sp = 0u;
    for (;;) {
        sum = 0u; cnt = 0u; mine = 0u;
#pragma unroll
        for (unsigned j = 0; j < 16; ++j) { const unsigned c = xb_ld(&bar[XB_XCNT(j)]); sum += c; cnt += (c > 0u) ? 1u : 0u; mine = (j == x) ? c : mine; }
        if (sum == G) break;
        __builtin_amdgcn_s_sleep(1);
        if ((++sp & 255u) == 0u) { if (xb_ld(&bar[XB_TMO])) break; if (sp > XB_SPIN_CAP) { atomicAdd(&bar[XB_TMO], 1u); break; } }
    }
    nloc = mine > 0u ? mine : 1u; nx = cnt > 0u ? cnt : 1u;
}

__device__ __forceinline__ void xcd_barrier(const XcdBarrier& b) {
    asm volatile("s_waitcnt vmcnt(0)" ::: "memory");
    __syncthreads();
    if (threadIdx.x == 0) {
        unsigned* bar = b.bar;
        __builtin_amdgcn_s_waitcnt(0);
        unsigned nloc = b.st[0], nx = b.st[1];
        if (nloc == 0u) { xcd_barrier_complete(bar, b.x, nloc, nx); b.st[0] = nloc; b.st[1] = nx; }
        const unsigned old = xb_add(&bar[XB_XSUB(b.x)], 1u);
        const unsigned gen = old / nloc;
        if (old + 1u == (gen + 1u) * nloc) {
            __builtin_amdgcn_fence(__ATOMIC_RELEASE, "agent");
            asm volatile("s_waitcnt vmcnt(0)" ::: "memory");
            const unsigned og = xb_add(&bar[XB_TOP], 1u);
            const unsigned tg = og / nx;
            if (og + 1u == (tg + 1u) * nx) xb_add(&bar[XB_TOPGEN], 1u);
            else XB_SPIN(xb_ld(&bar[XB_TOPGEN]) == tg, bar);
            __builtin_amdgcn_fence(__ATOMIC_ACQUIRE, "agent");
            xb_add(&bar[XB_XGEN(b.x)], 1u);
            asm volatile("s_waitcnt vmcnt(0)" ::: "memory");
        } else {
            XB_SPIN(xb_ld(&bar[XB_XGEN(b.x)]) == gen, bar);
            __builtin_amdgcn_fence(__ATOMIC_ACQUIRE, "agent");
            asm volatile("s_waitcnt vmcnt(0)" ::: "memory");
        }
    }
    __syncthreads();
}

__global__ void __launch_bounds__(512, 2) fwd_kernel(Args a) {
    extern __shared__ __attribute__((aligned(16))) unsigned char lds_raw[];
    LAS unsigned char* lds = (LAS unsigned char*)lds_raw;
    cg::grid_group grid = cg::this_grid();
    const int G = gridDim.x, c = blockIdx.x;
    unsigned char* ws = a.ws;
    unsigned* barw = (unsigned*)(ws + WS_BAR);
    if (blockIdx.x == 0) for (int i = threadIdx.x; i < XCD_BAR_WORDS; i += 512) barw[i] = 0u;
    if (threadIdx.x < 2) ((volatile LAS unsigned*)(lds + LDS_ST))[threadIdx.x] = 0u;
    grid.sync();
    const XcdBarrier bar = xcd_barrier_post(barw, (volatile LAS unsigned*)(lds + LDS_ST));
    float* slots = (float*)(ws + WS_SLOTS);
    bf16* XB = (bf16*)(ws + WS_XB);
#pragma unroll 1
    for (int l = 0; l < DEPTH; ++l) {
#pragma unroll 1
        for (int ph = 0; ph < 11; ++ph) {
            if (ph == 0) { if (l != 0) continue;
                convert_items(lds, a, 0, 0, CI_ALL, c * 8 + (tid_l() >> 6), G * 8); xprep_phase(a); }
            else if (ph == 7 || ph == 8 || ph == 9) continue;
            else if (ph == 6) {
                pg8::Gemm g{XB, (const bf16*)(ws + (l == 0 ? WS_WUP : WS_WUP1)), DM, DM, DM};
                pg8::SchedConv S{G, c};
                pg8::EpiConv E{(bf16*)(ws + WS_ACT), slots, a.in[I_FCW] + (size_t)l * 3 * UPC, (LAS float*)(lds + 131072)};
                pg8::gemm_phase<pg8::EpiConv, pg8::SchedConv, true, true>(lds, g, S, E);
                if (l + 1 < DEPTH) {
                    const bool idle = (G == 256); const int wv = tid_l() >> 6;
                    if (!idle || c >= 150) convert_items(lds, a, l + 1, 0, CI_B, idle ? (c - 150) * 8 + wv : c * 8 + wv, idle ? 106 * 8 : G * 8);
                }
            }
            else if (ph == 1) {
                const bf16* Bt = (const bf16*)(ws + WS_WIN) + (size_t)0 * DM;
                pg8::Gemm g{XB, Bt, DM, DM, DM};
                pg8::SchedPlain S{M / 256, 3072 / 256, G, c, (size_t)256 * DM * 2, (size_t)256 * DM * 2};
                pg8::EpiAct E{(bf16*)(ws + WS_PA), 3072, slots, 0, (LAS float*)(lds + 131072)};
                pg8::gemm_phase<pg8::EpiAct, pg8::SchedPlain, true, true>(lds, g, S, E);
            }
            else if (ph == 3) {
                const bf16* Bt = (const bf16*)(ws + WS_WIN) + (size_t)3072 * DM;
                pg8::Gemm g{XB, Bt, DM, DM, DM};
                pg8::SchedPlain S{M / 256, 3072 / 256, G, c, (size_t)256 * DM * 2, (size_t)256 * DM * 2};
                pg8::EpiAct E{(bf16*)(ws + WS_PA), 3072, slots, 1, (LAS float*)(lds + 131072)};
                pg8::gemm_phase<pg8::EpiAct, pg8::SchedPlain, true, true>(lds, g, S, E);
            }
            else if (ph == 2) mixer_phase(lds, a, l);
            else if (ph == 4) {
                pg8::Gemm g{(const bf16*)(ws + WS_Y), (const bf16*)(ws + WS_WBR), 1536, 512, 512};
                pg8::SchedBranch S{M / 256, DM / 256, G, c};
                pg8::EpiGate E{(const bf16*)(ws + WS_PA), (bf16*)(ws + WS_MG)};
                pg8::gemm_phase<pg8::EpiGate, pg8::SchedBranch, true, true>(lds, g, S, E);
            }
            else if (ph == 5 || ph == 10) {
                const bool dn = ph == 10;
                pg8::Gemm g{dn ? (const bf16*)(ws + WS_ACT) : (const bf16*)(ws + WS_MG), dn ? (const bf16*)(ws + (l == 0 ? WS_WDN : WS_WDN1)) : (const bf16*)(ws + WS_WO), dn ? DFF : DM, dn ? DFF : DM, dn ? DFF : DM};
                pg8::SchedPlain S{M / 256, DM / 256, G, c, (size_t)256 * (dn ? DFF : DM) * 2, (size_t)256 * (dn ? DFF : DM) * 2};
                pg8::EpiRes E{(l == 0 && !dn) ? a.in[I_X] : (const float*)a.out, a.out, XB, slots};
                pg8::gemm_phase<pg8::EpiRes, pg8::SchedPlain, true, true>(lds, g, S, E);
                if (dn && l + 1 < DEPTH) convert_items(lds, a, l + 1, CI_B, CI_ALL, c * 8 + (tid_l() >> 6), G * 8);
            }
            xcd_barrier(bar);
        }
    }
    final_norm(a);
}

extern "C" void kernel_launch(void* const* d_in, const int* in_sizes, int n_in, void* d_out, int out_size, void* d_ws, size_t ws_size, hipStream_t stream) {
    static int grid = 0;
    if (grid == 0) {
        if (n_in != 18 || out_size != M * DM || ws_size < WS_END) { fprintf(stderr, "kernel_launch: unexpected shapes (n_in %d, out %d, ws %zu)\n", n_in, out_size, ws_size); grid = -1; return; }
        int dev = 0, cus = 0, per_cu = 0;
        hipGetDevice(&dev); hipDeviceGetAttribute(&cus, hipDeviceAttributeMultiprocessorCount, dev);
        if (hipFuncSetAttribute((const void*)fwd_kernel, hipFuncAttributeMaxDynamicSharedMemorySize, LDS_BYTES) != hipSuccess) { fprintf(stderr, "kernel_launch: hipFuncSetAttribute failed\n"); grid = -1; return; }
        if (hipOccupancyMaxActiveBlocksPerMultiprocessor(&per_cu, (const void*)fwd_kernel, 512, LDS_BYTES) != hipSuccess || per_cu < 1) { fprintf(stderr, "kernel_launch: occupancy query failed (%d)\n", per_cu); grid = -1; return; }
        grid = cus;
    }
    if (grid < 0) return;
    Args a{};
    for (int i = 0; i < 18; ++i) a.in[i] = (const float*)d_in[i];
    a.out = (float*)d_out; a.ws = (unsigned char*)d_ws;
    void* args[] = {&a};
    hipError_t e = hipLaunchCooperativeKernel((const void*)fwd_kernel, dim3(grid), dim3(512), args, LDS_BYTES, stream);
    if (e != hipSuccess) fprintf(stderr, "kernel_launch: cooperative launch failed: %s (grid %d)\n", hipGetErrorString(e), grid);
}
```

```cpp
#include <hip/hip_runtime.h>
#include <hip/hip_cooperative_groups.h>
#include <cstdio>
#include <cstdint>
namespace cg = cooperative_groups;

namespace pg8 {
#define PG8_LAS __attribute__((address_space(3)))
typedef unsigned short bf16_t;
typedef short bf16x8 __attribute__((ext_vector_type(8)));
typedef float f32x4 __attribute__((ext_vector_type(4)));
typedef unsigned u32x4 __attribute__((ext_vector_type(4)));
typedef unsigned u32x2 __attribute__((ext_vector_type(2)));
constexpr int BM = 256, BK = 64, HALF = 128, HTB = HALF * BK * 2  , STAGE_BYTES = 8 * HTB, NXCD = 8, WGM = 8;

__host__ __device__ __forceinline__ int lds_byte(int r, int c) { const int st = (r >> 4) * 2 + (c >> 5), rr = r & 15, cc = c & 31, ob = rr * 64 + cc * 2; return st * 1024 + (ob ^ (((ob >> 9) & 1) << 5)); }
__host__ __device__ __forceinline__ void stage_rc(int b, int& R, int& C) { const int st = b / 1024, sb = b % 1024, swz = sb ^ (((sb >> 9) & 1) << 5); R = (st >> 1) * 16 + swz / 64; C = (st & 1) * 32 + (swz % 64) / 2; }
__host__ __device__ __forceinline__ int perm32(int rho) { const int n = rho >> 4, i = rho & 15; return 8 * (i >> 2) + 4 * n + (i & 3); }

struct Unit { int pm, pn, sub; size_t aoff, boff; };
struct Gemm { const bf16_t* A; const bf16_t* Bt; int lda, ldb, K; };

__device__ __forceinline__ unsigned cvt_pk_bf16(float lo, float hi) { unsigned r; asm volatile("s_nop 0\n\tv_cvt_pk_bf16_f32 %0, %1, %2" : "=v"(r) : "v"(lo), "v"(hi)); return r; }
typedef float f32x2 __attribute__((ext_vector_type(2)));
__device__ __forceinline__ f32x2 gelu_pk(f32x2 v) {
    const f32x2 av = __builtin_elementwise_abs(v), d = av * 0.2316418882f + 1.0f;
    f32x2 t; t.x = __builtin_amdgcn_rcpf(d.x); t.y = __builtin_amdgcn_rcpf(d.y);
    f32x2 q = t * 0.5307027145f + (-0.7265760135f); q = q * t + 0.7107068705f; q = q * t + (-0.142248368f); q = q * t + 0.127414796f; q = q * t;
    const f32x2 s = (v * v) * (-0.72134752044f);
    f32x2 e; e.x = __builtin_amdgcn_exp2f(s.x); e.y = __builtin_amdgcn_exp2f(s.y);
    const f32x2 m = v * (q * e), r = v - m;
    f32x2 o; o.x = v.x < 0.f ? m.x : r.x; o.y = v.y < 0.f ? m.y : r.y; return o;
}

template <class Epi, class Sched, bool ALIGN_EPI = false, bool SP2 = false>
__device__ __forceinline__ void gemm_phase(PG8_LAS unsigned char* lds, const Gemm g, const Sched& S, const Epi& E) {
    int tid_ = threadIdx.x; asm volatile("" : "+v"(tid_));
    const int tid = tid_, wid = __builtin_amdgcn_readfirstlane(tid >> 6), lane = tid & 63, wr = wid >> 2, wc = wid & 3, fr = lane & 15, fq = lane >> 4;
    const int K = g.K, nt = K / BK;
    unsigned voffA[2], voffB[2];
#pragma unroll
    for (int i = 0; i < 2; ++i) { int R, C; stage_rc(tid * 16 + i * 8192, R, C); const int Rb = Epi::PERM ? ((R & ~31) + perm32(R & 31)) : R;
        voffA[i] = (unsigned)(R * g.lda + C) * 2u; voffB[i] = (unsigned)(Rb * g.ldb + C) * 2u; }
    const size_t kstep = (size_t)(BK * 2);
    const size_t hstepA = (size_t)HALF * g.lda * 2, hstepB = (size_t)HALF * g.ldb * 2;
    const unsigned ldsw = (unsigned)wid * 1024u;
    const int aoff = lds_byte(wr * 64 + fr, fq * 8), boff = lds_byte(wc * 32 + fr, fq * 8);
#define PG8_SA(b, h) (((b) * 2 + (h)) * HTB)
#define PG8_SB(b, h) ((4 + (b) * 2 + (h)) * HTB)
#define PG8_STAGE(bufoff, gbase, voff) do { _Pragma("unroll") for (int _i = 0; _i < 2; ++_i) \
        __builtin_amdgcn_global_load_lds((const unsigned*)((const char*)(gbase) + (voff)[_i]), (PG8_LAS unsigned*)(lds + (bufoff) + ldsw + _i * 8192), 16, 0, 0); } while (0)
#define PG8_LDA(dst, b, h) do { _Pragma("unroll") for (int m = 0; m < 4; ++m) _Pragma("unroll") for (int k = 0; k < 2; ++k) dst[m][k] = *(const PG8_LAS bf16x8*)(lds + PG8_SA(b, h) + aoff + m * 2048 + k * 1024); } while (0)
#define PG8_LDB(dst, b, h) do { _Pragma("unroll") for (int n = 0; n < 2; ++n) _Pragma("unroll") for (int k = 0; k < 2; ++k) dst[n][k] = *(const PG8_LAS bf16x8*)(lds + PG8_SB(b, h) + boff + n * 2048 + k * 1024); } while (0)
#define PG8_MMA(ai, bj, At, Bt) do { __builtin_amdgcn_s_setprio(1); _Pragma("unroll") for (int m = 0; m < 4; ++m) _Pragma("unroll") for (int n = 0; n < 2; ++n) _Pragma("unroll") for (int k = 0; k < 2; ++k) \
        acc[ai][bj][m][n] = __builtin_amdgcn_mfma_f32_16x16x32_bf16(Bt[n][k], At[m][k], acc[ai][bj][m][n], 0, 0, 0); __builtin_amdgcn_s_setprio(0); } while (0)
#define PG8_WAIT_V(n) asm volatile("s_waitcnt vmcnt(" #n ")" ::: "memory")
#define PG8_WAIT_L(n) asm volatile("s_waitcnt lgkmcnt(" #n ")" ::: "memory")
#define PG8_BAR __builtin_amdgcn_s_barrier()
#define PG8_SCHED __builtin_amdgcn_sched_barrier(0)
    Unit cur, nxt; int ui = 0;
    if (!S.next(0, cur)) return;
    f32x4 acc[2][2][4][2];
#pragma unroll
    for (int a = 0; a < 2; ++a)
#pragma unroll
        for (int b = 0; b < 2; ++b)
#pragma unroll
            for (int m = 0; m < 4; ++m)
#pragma unroll
                for (int n = 0; n < 2; ++n) acc[a][b][m][n] = (f32x4){0.f, 0.f, 0.f, 0.f};
    bf16x8 At[4][2], B0[2][2], B1[2][2];
    const char* cA = (const char*)g.A + cur.aoff; const char* cB = (const char*)g.Bt + cur.boff;
    if constexpr (SP2) {
        PG8_STAGE(PG8_SB(0, 0), cB, voffB); PG8_STAGE(PG8_SB(0, 1), cB + hstepB, voffB); PG8_STAGE(PG8_SA(0, 0), cA, voffA); PG8_STAGE(PG8_SA(0, 1), cA + hstepA, voffA);
        if (wr == 1) PG8_BAR;
        PG8_WAIT_V(2); PG8_BAR;
        PG8_STAGE(PG8_SB(1, 0), cB + kstep, voffB); PG8_STAGE(PG8_SA(1, 0), cA + kstep, voffA); PG8_STAGE(PG8_SB(1, 1), cB + hstepB + kstep, voffB);
        PG8_WAIT_V(6); PG8_BAR;
    } else {
        PG8_STAGE(PG8_SB(0, 0), cB, voffB); PG8_STAGE(PG8_SA(0, 0), cA, voffA); PG8_STAGE(PG8_SB(0, 1), cB + hstepB, voffB); PG8_STAGE(PG8_SA(0, 1), cA + hstepA, voffA);
        if (wr == 1) PG8_BAR;
        PG8_WAIT_V(4); PG8_BAR;
        PG8_STAGE(PG8_SB(1, 0), cB + kstep, voffB); PG8_STAGE(PG8_SA(1, 0), cA + kstep, voffA); PG8_STAGE(PG8_SB(1, 1), cB + hstepB + kstep, voffB);
        PG8_WAIT_V(6); PG8_BAR;
    }
    for (;;) {
        const bool has_next = S.next(ui + 1, nxt);
        const char* nA = has_next ? (const char*)g.A + nxt.aoff : cA; const char* nB = has_next ? (const char*)g.Bt + nxt.boff : cB;
        for (int t = 0; t < nt; t += 2) {
            const bool last = (t == nt - 2);
            const char* a1 = cA + (size_t)(t + 1) * kstep;
            const char* a2 = last ? nA : cA + (size_t)(t + 2) * kstep; const char* b2 = last ? nB : cB + (size_t)(t + 2) * kstep;
            const char* a3 = a2 + kstep; const char* b3 = b2 + kstep;
            if constexpr (SP2) {
            PG8_LDB(B0, 0, 0); PG8_LDB(B1, 0, 1); PG8_SCHED; PG8_LDA(At, 0, 0); PG8_STAGE(PG8_SA(1, 1), a1 + hstepA, voffA);
            PG8_WAIT_V(8); PG8_WAIT_L(0); PG8_BAR; PG8_MMA(0, 0, At, B0); PG8_MMA(0, 1, At, B1); PG8_BAR; PG8_SCHED;
            PG8_LDA(At, 0, 1); PG8_STAGE(PG8_SB(0, 0), b2, voffB); PG8_STAGE(PG8_SB(0, 1), b2 + hstepB, voffB); PG8_STAGE(PG8_SA(0, 0), a2, voffA);
            PG8_WAIT_V(8); PG8_WAIT_L(0); PG8_BAR; PG8_MMA(1, 0, At, B0); PG8_MMA(1, 1, At, B1); PG8_BAR; PG8_SCHED;
            PG8_LDB(B0, 1, 0); PG8_LDB(B1, 1, 1); PG8_SCHED; PG8_LDA(At, 1, 0); PG8_STAGE(PG8_SA(0, 1), a2 + hstepA, voffA);
            PG8_WAIT_V(8); PG8_WAIT_L(0); PG8_BAR; PG8_MMA(0, 0, At, B0); PG8_MMA(0, 1, At, B1); PG8_BAR; PG8_SCHED;
            PG8_LDA(At, 1, 1); PG8_STAGE(PG8_SB(1, 0), b3, voffB); PG8_STAGE(PG8_SB(1, 1), b3 + hstepB, voffB); PG8_STAGE(PG8_SA(1, 0), a3, voffA);
            PG8_WAIT_V(8); PG8_WAIT_L(0); PG8_BAR; PG8_MMA(1, 0, At, B0); PG8_MMA(1, 1, At, B1); PG8_BAR; PG8_SCHED;
            } else {
            PG8_LDB(B0, 0, 0); PG8_SCHED; PG8_LDA(At, 0, 0); PG8_STAGE(PG8_SA(1, 1), a1 + hstepA, voffA);
            PG8_WAIT_L(8); PG8_BAR; PG8_WAIT_L(0); PG8_MMA(0, 0, At, B0); PG8_BAR; PG8_SCHED;
            PG8_LDB(B1, 0, 1); PG8_STAGE(PG8_SB(0, 0), b2, voffB);
            PG8_BAR; PG8_WAIT_L(0); PG8_MMA(0, 1, At, B1); PG8_BAR;
            PG8_LDA(At, 0, 1); PG8_STAGE(PG8_SA(0, 0), a2, voffA);
            PG8_BAR; PG8_WAIT_L(0); PG8_MMA(1, 0, At, B0); PG8_BAR; PG8_SCHED;
            PG8_STAGE(PG8_SB(0, 1), b2 + hstepB, voffB);
            PG8_WAIT_V(6); PG8_BAR; PG8_MMA(1, 1, At, B1); PG8_BAR;
            PG8_LDB(B0, 1, 0); PG8_SCHED; PG8_LDA(At, 1, 0); PG8_STAGE(PG8_SA(0, 1), a2 + hstepA, voffA);
            PG8_WAIT_L(8); PG8_BAR; PG8_WAIT_L(0); PG8_MMA(0, 0, At, B0); PG8_BAR; PG8_SCHED;
            PG8_LDB(B1, 1, 1); PG8_STAGE(PG8_SB(1, 0), b3, voffB);
            PG8_BAR; PG8_WAIT_L(0); PG8_MMA(0, 1, At, B1); PG8_BAR;
            PG8_LDA(At, 1, 1); PG8_STAGE(PG8_SA(1, 0), a3, voffA);
            PG8_BAR; PG8_WAIT_L(0); PG8_MMA(1, 0, At, B0); PG8_BAR; PG8_SCHED;
            PG8_STAGE(PG8_SB(1, 1), b3 + hstepB, voffB);
            PG8_WAIT_V(6); PG8_BAR; PG8_MMA(1, 1, At, B1); PG8_BAR;
            }
        }
        if constexpr (ALIGN_EPI) { if (wr == 0) PG8_BAR; }
        E(acc, cur, wr, wc, fr, fq);
        if (!has_next) break;
        if (E.zero_after(cur)) {
#pragma unroll
        for (int a = 0; a < 2; ++a)
#pragma unroll
            for (int b = 0; b < 2; ++b)
#pragma unroll
                for (int m = 0; m < 4; ++m)
#pragma unroll
                    for (int n = 0; n < 2; ++n) acc[a][b][m][n] = (f32x4){0.f, 0.f, 0.f, 0.f};
        }
        cur = nxt; cA = nA; cB = nB; ++ui;
        if constexpr (ALIGN_EPI) { if (wr == 1) PG8_BAR; }
    }
    PG8_WAIT_V(0);
    if constexpr (!ALIGN_EPI) { if (wr == 0) PG8_BAR; }
    PG8_BAR;
#undef PG8_SA
#undef PG8_SB
#undef PG8_STAGE
#undef PG8_LDA
#undef PG8_LDB
#undef PG8_MMA
#undef PG8_WAIT_V
#undef PG8_WAIT_L
#undef PG8_BAR
#undef PG8_SCHED
}

__device__ __forceinline__ void tile_map(int L, int nM, int nN, int& pm, int& pn) {
    const int nwg = nM * nN; int wgid = L;
    { const int q = nwg / NXCD, r = nwg % NXCD, xcd = wgid % NXCD, off = wgid / NXCD; wgid = (xcd < r ? xcd * (q + 1) : r * (q + 1) + (xcd - r) * q) + off; }
    const int nig = WGM * nN, gid = wgid / nig, fm = gid * WGM, gsz = (nM - fm) < WGM ? (nM - fm) : WGM;
    pm = fm + ((wgid % nig) % gsz); pn = (wgid % nig) / gsz;
}
struct SchedPlain {
    int nM, nN, G, c; size_t astride, bstride;
    __device__ __forceinline__ bool next(int i, Unit& u) const {
        const long L = (long)i * G + c; if (L >= (long)nM * nN) return false;
        tile_map((int)L, nM, nN, u.pm, u.pn); u.sub = 0; u.aoff = (size_t)u.pm * astride; u.boff = (size_t)u.pn * bstride; return true;
    }
};
struct SchedBranch {
    int nM, nN, G, c;
    __device__ __forceinline__ bool next(int i, Unit& u) const {
        const int t = i / 3, s = i - 3 * t; const long L = (long)t * G + c; if (L >= (long)nM * nN) return false;
        tile_map((int)L, nM, nN, u.pm, u.pn); u.sub = s;
        u.aoff = (size_t)u.pm * (256 * 1536 * 2) + (size_t)s * (512 * 2); u.boff = ((size_t)s * 1024 + (size_t)u.pn * 256) * (512 * 2); return true;
    }
};

__device__ __forceinline__ float row_rstd(const float* slots, int row) {
    const f32x4* sp = (const f32x4*)(slots + (size_t)row * 16);
    const f32x4 s = (sp[0] + sp[1]) + (sp[2] + sp[3]);
    return rsqrtf(((s[0] + s[1]) + (s[2] + s[3])) * (1.0f / 1024.0f) + 1e-6f);
}
__device__ __forceinline__ float sigmoid_c(float z) { z = fminf(fmaxf(z, -30.f), 30.f); return 1.0f + __expf(-z); }

struct EpiAct {
    static constexpr bool PERM = true, AFTER_DRAIN = false;
    bf16_t* O; int ldc; const float* slots; int mode; PG8_LAS float* R;
    __device__ __forceinline__ bool zero_after(const Unit&) const { return true; }
    __device__ __forceinline__ void operator()(f32x4 (&acc)[2][2][4][2], const Unit& u, int wr, int wc, int fr_, int fq_) const {
        int fr = fr_, fq = fq_; asm volatile("" : "+v"(fr), "+v"(fq));
        { const int tl = (wr * 4 + wc) * 64 + fq * 16 + fr; if (tl < 256) R[tl] = row_rstd(slots, u.pm * BM + tl); }
        asm volatile("s_waitcnt vmcnt(0) lgkmcnt(0)" ::: "memory"); __builtin_amdgcn_s_barrier(); asm volatile("" ::: "memory");
        const int row0 = u.pm * BM + wr * 64 + fr, col0 = u.pn * BM + wc * 32 + 8 * fq;
        const int act = (mode == 1) ? 2 : ((mode == 0 && u.pn < 4) ? 1 : 0);
#pragma unroll
        for (int ai = 0; ai < 2; ++ai)
#pragma unroll
            for (int m = 0; m < 4; ++m) {
                const int row = row0 + ai * HALF + m * 16; const float rs = R[ai * HALF + wr * 64 + m * 16 + fr];
                bf16_t* rowp = O + (size_t)row * ldc + col0;
#pragma unroll
                for (int bj = 0; bj < 2; ++bj) {
                    f32x4 v0 = acc[ai][bj][m][0] * rs, v1 = acc[ai][bj][m][1] * rs;
                    if (act == 1) { f32x2 a = gelu_pk((f32x2){v0[0], v0[1]}), b = gelu_pk((f32x2){v0[2], v0[3]}), c = gelu_pk((f32x2){v1[0], v1[1]}), d = gelu_pk((f32x2){v1[2], v1[3]});
                        v0 = (f32x4){a.x, a.y, b.x, b.y}; v1 = (f32x4){c.x, c.y, d.x, d.y}; }
                    else if (act == 2) { v0 = (f32x4){sigmoid_c(v0[0]), sigmoid_c(v0[1]), sigmoid_c(v0[2]), sigmoid_c(v0[3])}; v1 = (f32x4){sigmoid_c(v1[0]), sigmoid_c(v1[1]), sigmoid_c(v1[2]), sigmoid_c(v1[3])}; }
                    u32x4 w; w.x = cvt_pk_bf16(v0[0], v0[1]); w.y = cvt_pk_bf16(v0[2], v0[3]); w.z = cvt_pk_bf16(v1[0], v1[1]); w.w = cvt_pk_bf16(v1[2], v1[3]);
                    *(u32x4*)(rowp + bj * HALF) = w; }
            }
    }
};
__device__ __forceinline__ void unpack8(const u32x4 v, float (&f)[8]) {
    f[0] = __uint_as_float(v.x << 16); f[1] = __uint_as_float(v.x & 0xffff0000u); f[2] = __uint_as_float(v.y << 16); f[3] = __uint_as_float(v.y & 0xffff0000u);
    f[4] = __uint_as_float(v.z << 16); f[5] = __uint_as_float(v.z & 0xffff0000u); f[6] = __uint_as_float(v.w << 16); f[7] = __uint_as_float(v.w & 0xffff0000u);
}
struct EpiGate {
    static constexpr bool PERM = true, AFTER_DRAIN = false;
    const bf16_t* Gt; bf16_t* O;
    __device__ __forceinline__ bool zero_after(const Unit& u) const { return u.sub == 2; }
    __device__ __forceinline__ void operator()(f32x4 (&acc)[2][2][4][2], const Unit& u, int wr, int wc, int fr_, int fq_) const {
        int fr = fr_, fq = fq_; asm volatile("" : "+v"(fr), "+v"(fq));
        const int row0 = u.pm * BM + wr * 64 + fr, col0 = u.pn * BM + wc * 32 + 8 * fq; const int s = u.sub;
        u32x4 ga[2][2], gb[2][2];
#define GATE_LOAD(st, g) do { const bf16_t* gp_ = Gt + (size_t)(row0 + ((g) >> 2) * HALF + ((g) & 3) * 16) * 3072 + s * 1024 + col0; \
            ga[st][0] = *(const u32x4*)(gp_); ga[st][1] = *(const u32x4*)(gp_ + HALF); \
            if (s < 2) { gb[st][0] = *(const u32x4*)(gp_ + 1024); gb[st][1] = *(const u32x4*)(gp_ + 1024 + HALF); } else { gb[st][0] = ga[st][0]; gb[st][1] = ga[st][1]; } } while (0)
        GATE_LOAD(0, 0);
#pragma unroll
        for (int g = 0; g < 8; ++g) {
            const int ai = g >> 2, m = g & 3, st = g & 1;
            if (g + 1 < 8) GATE_LOAD(st ^ 1, g + 1);
            __builtin_amdgcn_sched_barrier(0);
            const int row = row0 + ai * HALF + m * 16;
#pragma unroll
            for (int bj = 0; bj < 2; ++bj) {
                const int col = col0 + bj * HALF;
                float f[8]; unpack8(ga[st][bj], f);
#pragma unroll
                for (int e = 0; e < 8; ++e) f[e] = __builtin_amdgcn_rcpf(f[e]);
                if (s < 2) { float h[8]; unpack8(gb[st][bj], h);
#pragma unroll
                    for (int e = 0; e < 8; ++e) f[e] *= h[e]; }
                f32x4 v0 = acc[ai][bj][m][0], v1 = acc[ai][bj][m][1];
                v0 = v0 * (f32x4){f[0], f[1], f[2], f[3]}; v1 = v1 * (f32x4){f[4], f[5], f[6], f[7]};
                acc[ai][bj][m][0] = v0; acc[ai][bj][m][1] = v1;
                if (s == 2) { u32x4 w; w.x = cvt_pk_bf16(v0[0], v0[1]); w.y = cvt_pk_bf16(v0[2], v0[3]); w.z = cvt_pk_bf16(v1[0], v1[1]); w.w = cvt_pk_bf16(v1[2], v1[3]);
                    *(u32x4*)(O + (size_t)row * 1024 + col) = w; }
            }
            __builtin_amdgcn_sched_barrier(0);
        }
#undef GATE_LOAD
        __builtin_amdgcn_s_waitcnt(0x0F70);
    }
};
struct EpiRes {
    static constexpr bool PERM = false, AFTER_DRAIN = false;
    const float* Xin; float* Xout; bf16_t* XB; float* slots;
    __device__ __forceinline__ bool zero_after(const Unit&) const { return true; }
    __device__ __forceinline__ void operator()(f32x4 (&acc)[2][2][4][2], const Unit& u, int wr, int wc, int fr_, int fq_) const {
        int fr = fr_, fq = fq_; asm volatile("" : "+v"(fr), "+v"(fq));
        const int row0 = u.pm * BM + wr * 64 + fr, col0 = u.pn * BM + wc * 32 + 4 * fq;
        f32x4 xs[2][4];
#define RES_LOAD(st, g) do { const float* p_ = Xin + (size_t)(row0 + ((g) >> 2) * HALF + ((g) & 3) * 16) * 1024 + col0; \
            xs[st][0] = *(const f32x4*)(p_); xs[st][1] = *(const f32x4*)(p_ + 16); xs[st][2] = *(const f32x4*)(p_ + HALF); xs[st][3] = *(const f32x4*)(p_ + HALF + 16); } while (0)
        RES_LOAD(0, 0);
#pragma unroll
        for (int g = 0; g < 8; ++g) {
            const int ai = g >> 2, m = g & 3, st = g & 1;
            if (g + 1 < 8) RES_LOAD(st ^ 1, g + 1);
            __builtin_amdgcn_sched_barrier(0);
            const int row = row0 + ai * HALF + m * 16; const size_t off = (size_t)row * 1024 + col0; float ss = 0.f;
#pragma unroll
            for (int bj = 0; bj < 2; ++bj)
#pragma unroll
                for (int n = 0; n < 2; ++n) {
                    const f32x4 xn = xs[st][bj * 2 + n] + acc[ai][bj][m][n];
                    *(f32x4*)(Xout + off + bj * HALF + n * 16) = xn;
                    ss += (xn[0] * xn[0] + xn[1] * xn[1]) + (xn[2] * xn[2] + xn[3] * xn[3]);
                    u32x2 w; w.x = cvt_pk_bf16(xn[0], xn[1]); w.y = cvt_pk_bf16(xn[2], xn[3]);
                    *(u32x2*)(XB + off + bj * HALF + n * 16) = w; }
            ss += __shfl_xor(ss, 16); ss += __shfl_xor(ss, 32);
            if (fq == 0) slots[(size_t)row * 16 + u.pn * 4 + wc] = ss;
            __builtin_amdgcn_sched_barrier(0);
        }
#undef RES_LOAD
    }
};
struct SchedConv {
    int G, c;
    __device__ __forceinline__ bool next(int i, Unit& u) const {
        const long L = (long)i * G + c; if (L >= 65L * 22L) return false;
        tile_map((int)L, 65, 22, u.pm, u.pn); u.sub = 0;
        u.aoff = (size_t)((long)(254 * u.pm - 2) * 2048L); u.boff = (size_t)u.pn * (256 * 1024 * 2); return true;
    }
};
__device__ __forceinline__ float dpp_f(float oldv, float src, const int ctrl_sel) {
    const int o = __float_as_int(oldv), v = __float_as_int(src);
    return __int_as_float(ctrl_sel == 1 ? __builtin_amdgcn_update_dpp(o, v, 0x111, 0xf, 0xf, false) : __builtin_amdgcn_update_dpp(o, v, 0x112, 0xf, 0xf, false));
}
__device__ __forceinline__ float ror_f(float src, const int n) {
    const int v = __float_as_int(src);
    return __int_as_float(n == 1 ? __builtin_amdgcn_mov_dpp(v, 0x121, 0xf, 0xf, false) : __builtin_amdgcn_mov_dpp(v, 0x122, 0xf, 0xf, false));
}
struct EpiConv {
    static constexpr bool PERM = true, AFTER_DRAIN = false;
    bf16_t* ACT; const float* slots; const float* cw; PG8_LAS float* H;
    __device__ __forceinline__ bool zero_after(const Unit&) const { return true; }
    __device__ __forceinline__ void operator()(f32x4 (&acc)[2][2][4][2], const Unit& u, int wr, int wc, int fr_, int fq_) const {
        int fr = fr_, fq = fq_; asm volatile("" : "+v"(fr), "+v"(fq));
        const int arow0 = 254 * u.pm - 2, cl = wc * 32 + 8 * fq;
        PG8_LAS float* R = H + 3 * 2 * 256;
        PG8_LAS float* CWl = R + 256;
        { const int tl = (wr * 4 + wc) * 64 + fq * 16 + fr;
          if (tl < 256) { int row = arow0 + tl; row = row < 0 ? 0 : (row > 16383 ? 16383 : row); R[tl] = row_rstd(slots, row); }
          else if (tl < 448) { const int k = (tl - 256) >> 6, col = ((tl - 256) & 63) * 4; *(PG8_LAS f32x4*)(CWl + k * 256 + col) = *(const f32x4*)(cw + k * 5632 + (col < 128 ? 128 * u.pn + col : 2816 + 128 * u.pn + col - 128)); } }
#pragma unroll
        for (int ai = 0; ai < 2; ++ai) { const int s = 2 * ai + wr;
            if (s < 3 && fr >= 14) {
#pragma unroll
                for (int bj = 0; bj < 2; ++bj)
#pragma unroll
                    for (int n = 0; n < 2; ++n) *(PG8_LAS f32x4*)(H + (s * 2 + (fr - 14)) * 256 + bj * HALF + cl + 4 * n) = acc[ai][bj][3][n]; } }
        asm volatile("s_waitcnt vmcnt(0) lgkmcnt(0)" ::: "memory"); __builtin_amdgcn_s_barrier(); asm volatile("" ::: "memory");
#pragma unroll
        for (int ai = 0; ai < 2; ++ai)
#pragma unroll
            for (int m = 0; m < 4; ++m) { const float rs = R[ai * HALF + wr * 64 + m * 16 + fr];
#pragma unroll
                for (int bj = 0; bj < 2; ++bj) { acc[ai][bj][m][0] = acc[ai][bj][m][0] * rs; acc[ai][bj][m][1] = acc[ai][bj][m][1] * rs; } }
        const int tbg = (arow0 + wr * 64) & 8191; const bool gedge = (tbg >= 8177) || (tbg <= 1);
#pragma unroll
        for (int n = 0; n < 2; ++n) {
            f32x4 wg[3], wv[3];
#pragma unroll
            for (int k = 0; k < 3; ++k) { wg[k] = *(const PG8_LAS f32x4*)(CWl + k * 256 + cl + 4 * n); wv[k] = *(const PG8_LAS f32x4*)(CWl + k * 256 + 128 + cl + 4 * n); }
#pragma unroll
            for (int ai = 0; ai < 2; ++ai) {
                const int s = 2 * ai + wr;
                f32x4 h1[2], h2[2];
#pragma unroll
                for (int bj = 0; bj < 2; ++bj) {
                    if (s > 0) { h1[bj] = *(const PG8_LAS f32x4*)(H + ((s - 1) * 2 + 1) * 256 + bj * HALF + cl + 4 * n) * R[64 * s - 1]; h2[bj] = *(const PG8_LAS f32x4*)(H + ((s - 1) * 2 + 0) * 256 + bj * HALF + cl + 4 * n) * R[64 * s - 2]; }
                    else { h1[bj] = (f32x4){0.f, 0.f, 0.f, 0.f}; h2[bj] = (f32x4){0.f, 0.f, 0.f, 0.f}; } }
#pragma unroll
                for (int m = 0; m < 4; ++m) {
                    const int lr = ai * HALF + wr * 64 + m * 16 + fr, t = arow0 + lr, tb = t & 8191;
                    const bool k1 = tb >= 1, k2 = tb >= 2;
                    float o[4];
#pragma unroll
                    for (int jj = 0; jj < 4; ++jj) {
                        float cv[2];
#pragma unroll
                        for (int bj = 0; bj < 2; ++bj) {
                            const float cur = acc[ai][bj][m][n][jj];
                            float o1, o2;
                            if (m > 0) { const float prv = acc[ai][bj][m - 1][n][jj]; o1 = ror_f(prv, 1); o2 = ror_f(prv, 2); }
                            else { o1 = h1[bj][jj]; o2 = (fr == 0) ? h2[bj][jj] : o1; }
                            float x1 = dpp_f(o1, cur, 1), x2 = dpp_f(o2, cur, 2);
                            if (ai == 0 && m == 0) { x1 = (gedge && !k1) ? 0.f : x1; x2 = (gedge && !k2) ? 0.f : x2; }
                            cv[bj] = bj == 0 ? (wg[0][jj] * x2 + wg[1][jj] * x1 + wg[2][jj] * cur) : (wv[0][jj] * x2 + wv[1][jj] * x1 + wv[2][jj] * cur);
                        }
                        o[jj] = cv[0] * __builtin_amdgcn_rcpf(1.0f + __expf(-cv[0])) * cv[1];
                    }
                    u32x2 pk; pk.x = cvt_pk_bf16(o[0], o[1]); pk.y = cvt_pk_bf16(o[2], o[3]);
                    if (lr >= 2 && t < 16384) *(u32x2*)(ACT + (size_t)t * 2816 + 128 * u.pn + cl + 4 * n) = pk;
                    asm volatile("" ::: "memory");
                }
            }
        }
    }
};
}

#define LAS __attribute__((address_space(3)))
typedef pg8::bf16_t bf16;
typedef pg8::f32x4 f32x4;
typedef pg8::u32x4 u32x4;
typedef pg8::u32x2 u32x2;
typedef pg8::bf16x8 bf16x8;
constexpr int DM = 1024, SEQ = 8192, M = 16384, DEPTH = 2, INC = 6144, DFF = 2816, UPC = 5632;
constexpr size_t MiB = 1u << 20;
constexpr size_t WS_BAR = 16384;
constexpr size_t WS_SLOTS = 1 * MiB;
constexpr size_t WS_WIN = 2 * MiB, WS_WBR = 14 * MiB, WS_WO = 17 * MiB, WS_WUP = 19 * MiB, WS_WDN = 30 * MiB;
constexpr size_t WS_XB = 36 * MiB;
constexpr size_t WS_PA = 68 * MiB;
constexpr size_t WS_Y = 164 * MiB;
constexpr size_t WS_MG = 212 * MiB;
constexpr size_t WS_AP = 68 * MiB;
constexpr size_t WS_ACT = 156 * MiB;
constexpr size_t WS_WUP1 = 244 * MiB, WS_WDN1 = 19 * MiB;
constexpr size_t WS_END = 255 * MiB;
constexpr int LDS_BYTES = 143360, LDS_ST = 143360 - 64;

struct Args { const float* in[18]; float* out; unsigned char* ws; };
enum { I_X = 0, I_NMIX, I_WIN, I_SLN, I_SW, I_SB, I_CBW, I_PW, I_PS, I_WA, I_WB, I_WC, I_WO, I_NFFN, I_WUP, I_FCW, I_WDN, I_NF };

__device__ __forceinline__ int tid_l() { int t = threadIdx.x; asm volatile("" : "+v"(t)); return t; }
__device__ __forceinline__ float wave_sum(float v) {
#pragma unroll
    for (int o = 1; o < 64; o <<= 1) v += __shfl_xor(v, o);
    return v;
}
__device__ __forceinline__ unsigned pk2(float lo, float hi) { return pg8::cvt_pk_bf16(lo, hi); }
__device__ __forceinline__ float bf_lo(unsigned w) { return __uint_as_float(w << 16); }
__device__ __forceinline__ float bf_hi(unsigned w) { return __uint_as_float(w & 0xffff0000u); }

struct TrItem { const float* W; bf16* WT; const float* ksc; int K, N, dst_row0, k0, n0; };
__device__ __forceinline__ void tr_load(const TrItem& t, f32x4 (&v)[16], int lane) {
    const int r = lane >> 4, c4 = (lane & 15) * 4;
#pragma unroll
    for (int i = 0; i < 16; ++i) v[i] = *(const f32x4*)(t.W + (size_t)(t.k0 + 4 * i + r) * t.N + t.n0 + c4);
}
__device__ __forceinline__ void tr_store(const TrItem& t, const f32x4 (&v)[16], LAS float* scr, int lane) {
    const int r = lane >> 4, c4 = (lane & 15) * 4;
#pragma unroll
    for (int i = 0; i < 16; ++i) { const float sc = t.ksc ? t.ksc[t.k0 + 4 * i + r] : 1.0f; LAS float* d = scr + (4 * i + r) * 65 + c4; d[0] = v[i][0] * sc; d[1] = v[i][1] * sc; d[2] = v[i][2] * sc; d[3] = v[i][3] * sc; }
    asm volatile("s_waitcnt lgkmcnt(0)" ::: "memory");
    const int c = lane & 7;
#pragma unroll
    for (int j = 0; j < 8; ++j) { const int n = (lane >> 3) + 8 * j; const LAS float* s = scr + (8 * c) * 65 + n;
        u32x4 o; o.x = pk2(s[0 * 65], s[1 * 65]); o.y = pk2(s[2 * 65], s[3 * 65]); o.z = pk2(s[4 * 65], s[5 * 65]); o.w = pk2(s[6 * 65], s[7 * 65]);
        *(u32x4*)(t.WT + (size_t)(t.dst_row0 + n) * t.K + t.k0 + 8 * c) = o; }
    asm volatile("s_waitcnt lgkmcnt(0)" ::: "memory");
}
constexpr int CI_IN = (DM / 64) * (INC / 64), CI_BR = (512 / 64) * (DM / 64), CI_O = (DM / 64) * (DM / 64), CI_UP = (DM / 64) * (UPC / 64), CI_DN = (DFF / 64) * (DM / 64);
constexpr int CI_A = CI_IN + 3 * CI_BR + CI_O, CI_B = CI_A + CI_UP, CI_ALL = CI_B + CI_DN;
__device__ __forceinline__ TrItem tr_decode(const Args& a, int l, int it) {
    unsigned char* ws = a.ws; TrItem t; int r = it;
    if (r < CI_IN) { const int nblk = INC / 64, kb = r / nblk, nb = r % nblk; t.W = a.in[I_WIN] + (size_t)l * DM * INC; t.K = DM; t.N = INC; t.WT = (bf16*)(ws + WS_WIN); t.dst_row0 = 64 * nb; t.ksc = a.in[I_NMIX] + l * DM; t.k0 = 64 * kb; t.n0 = 64 * nb; return t; } r -= CI_IN;
    if (r < 3 * CI_BR) { const int br = r / CI_BR; r -= br * CI_BR; const int nblk = DM / 64, kb = r / nblk, nb = r % nblk;
        t.W = a.in[I_WA + br] + (size_t)l * 512 * DM; t.K = 512; t.N = DM; t.WT = (bf16*)(ws + WS_WBR); t.dst_row0 = br * 1024 + 64 * nb; t.ksc = nullptr; t.k0 = 64 * kb; t.n0 = 64 * nb; return t; } r -= 3 * CI_BR;
    if (r < CI_O) { const int nblk = DM / 64, kb = r / nblk, nb = r % nblk; t.W = a.in[I_WO] + (size_t)l * DM * DM; t.K = DM; t.N = DM; t.WT = (bf16*)(ws + WS_WO); t.dst_row0 = 64 * nb; t.ksc = nullptr; t.k0 = 64 * kb; t.n0 = 64 * nb; return t; } r -= CI_O;
    if (r < CI_UP) { const int nblk = UPC / 64, kb = r / nblk, nb = r % nblk; const int n0 = 64 * nb; const int j = n0 < DFF ? n0 : n0 - DFF;
        t.W = a.in[I_WUP] + (size_t)l * DM * UPC; t.K = DM; t.N = UPC; t.WT = (bf16*)(ws + (l == 0 ? WS_WUP : WS_WUP1)); t.dst_row0 = 256 * (j / 128) + (j % 128) + (n0 < DFF ? 0 : 128); t.ksc = a.in[I_NFFN] + l * DM; t.k0 = 64 * kb; t.n0 = n0; return t; } r -= CI_UP;
    { const int nblk = DM / 64, kb = r / nblk, nb = r % nblk; t.W = a.in[I_WDN] + (size_t)l * DFF * DM; t.K = DFF; t.N = DM; t.WT = (bf16*)(ws + (l == 0 ? WS_WDN : WS_WDN1)); t.dst_row0 = 64 * nb; t.ksc = nullptr; t.k0 = 64 * kb; t.n0 = 64 * nb; return t; }
}
__device__ __forceinline__ void convert_items(LAS unsigned char* lds, const Args& a, int l, int it_lo, int it_hi, int wk, int nwk) {
    const int tidl = tid_l(), lane = tidl & 63, wave = tidl >> 6;
    LAS float* scr = (LAS float*)(lds + wave * 16640);
    int it = it_lo + wk; if (it >= it_hi) return;
    TrItem cur = tr_decode(a, l, it); f32x4 v[16]; tr_load(cur, v, lane);
    for (;;) {
        const int itn = it + nwk; const bool more = itn < it_hi;
        f32x4 w[16]; TrItem nxt = cur;
        if (more) { nxt = tr_decode(a, l, itn); tr_load(nxt, w, lane); }
        tr_store(cur, v, scr, lane);
        if (!more) break;
#pragma unroll
        for (int i = 0; i < 16; ++i) v[i] = w[i];
        cur = nxt; it = itn;
    }
}
__device__ __forceinline__ void xprep_phase(const Args& a) {
    const int tidl = tid_l(), lane = tidl & 63, wave = tidl >> 6;
    const int gw = blockIdx.x * 8 + wave, NGW = gridDim.x * 8;
    unsigned char* ws = a.ws;
    {
        const float* x = a.in[I_X]; bf16* xb = (bf16*)(ws + WS_XB); float* slots = (float*)(ws + WS_SLOTS);
        for (int m = gw; m < M; m += NGW) {
            const f32x4* xr = (const f32x4*)(x + (size_t)m * DM) + lane; f32x4 v[4]; float s = 0.f;
#pragma unroll
            for (int j = 0; j < 4; ++j) { v[j] = xr[64 * j]; s += (v[j][0] * v[j][0] + v[j][1] * v[j][1]) + (v[j][2] * v[j][2] + v[j][3] * v[j][3]); }
            s = wave_sum(s);
            u32x2* o8 = (u32x2*)(xb + (size_t)m * DM) + lane;
#pragma unroll
            for (int j = 0; j < 4; ++j) { u32x2 w; w.x = pk2(v[j][0], v[j][1]); w.y = pk2(v[j][2], v[j][3]); o8[64 * j] = w; }
            if (lane < 4) { f32x4 z = (f32x4){0.f, 0.f, 0.f, 0.f}; if (lane == 0) z[0] = s; ((f32x4*)(slots + (size_t)m * 16))[lane] = z; }
        }
    }
}

#define LDS_BAR() asm volatile("s_waitcnt lgkmcnt(0)\n\ts_barrier" ::: "memory")
__device__ __forceinline__ void mixer_phase(LAS unsigned char* lds, const Args& a, int l) {
    const int tid = tid_l(), lane = tid & 63, wid = tid >> 6, r16 = lane & 15, q = lane >> 4;
    LAS bf16* Wl = (LAS bf16*)lds;
    LAS bf16* Tl = (LAS bf16*)(lds + 34816);
    LAS float* Fl = (LAS float*)(lds + 69632);
    LAS bf16* Zl = (LAS bf16*)(lds + 70656);
    const bf16* PA = (const bf16*)(a.ws + WS_PA); bf16* Y = (bf16*)(a.ws + WS_Y);
    int cur_job = -1; bool have = false;
    u32x4 pf[5];
#pragma unroll
    for (int k = 0; k < 5; ++k) pf[k] = (u32x4){0u, 0u, 0u, 0u};
    const bool split = (gridDim.x == 256); const int cb = blockIdx.x;
    int sj = 0, srank = 0, sn = 1;
    if (split) { if (cb < 104) { sj = cb / 13; srank = cb % 13; sn = 13; } else if (cb < 168) { sj = 8 + (cb - 104) / 16; srank = (cb - 104) % 16; sn = 16; } else { sj = 12 + (cb - 168) / 22; srank = (cb - 168) % 22; sn = 22; } }
    for (int it = 0;; ++it) {
        int job, blk, jobn, blkn; bool okn;
        if (split) { blk = srank + it * sn; if (blk >= 128) break; job = sj; blkn = blk + sn; okn = blkn < 128; jobn = sj; }
        else { const int u = cb + it * (int)gridDim.x; if (u >= 2048) break; job = u & 15; blk = u >> 4; const int un = u + (int)gridDim.x; okn = un < 2048; jobn = un & 15; blkn = un >> 4; }
        const int R0 = blk * 128; const bool pre = okn && (jobn == job); const int R0n = blkn * 128;
        if (job != cur_job) {
            __syncthreads();
            if (job < 8) {
                const float* W = a.in[I_SW] + (size_t)(l * 8 + job) * 16384;
                for (int idx = tid; idx < 4096; idx += 512) { const int i = idx >> 5, j0 = (idx & 31) * 4; f32x4 w = *(const f32x4*)(W + i * 128 + j0);
                    if (i < 64 && j0 >= 64) w = (f32x4){0.f, 0.f, 0.f, 0.f};
                    u32x2 o; o.x = pk2(w[0], w[1]); o.y = pk2(w[2], w[3]); *(LAS u32x2*)(Wl + i * 136 + j0) = o; }
                if (tid < 128) Fl[tid] = a.in[I_SB][(l * 8 + job) * 128 + tid];
                else if (tid < 192) Fl[tid] = a.in[I_SLN][l * 512 + job * 64 + (tid - 128)];
            } else if (job >= 12) {
                const int g = job - 12; const float* W = a.in[I_PW] + (size_t)(l * 4 + g) * 16384;
                for (int idx = tid; idx < 4096; idx += 512) { const int c = idx & 127, d0 = (idx >> 7) * 4; const f32x4 w = *(const f32x4*)(W + c * 128 + d0);
#pragma unroll
                    for (int e = 0; e < 4; ++e) Wl[(d0 + e) * 136 + c] = (bf16)(pk2(w[e], 0.f) & 0xffffu); }
                if (tid < 128) Fl[tid] = a.in[I_PS][l * 512 + g * 128 + tid];
            }
            __syncthreads();
            cur_job = job; have = false;
        }
        if (job < 8) {
            const int g = job, vrow = tid >> 2, ch0 = (tid & 3) * 16, ui = 16 * wid + r16;
#define SGU_LOAD(R) do { const u32x4* src_ = (const u32x4*)(PA + (size_t)((R) + vrow) * 3072 + 512 + g * 64 + ch0); pf[0] = src_[0]; pf[1] = src_[1]; \
                const bf16* up_ = PA + (size_t)((R) + 16 * wid + (lane >> 3)) * 3072 + g * 64 + 8 * (lane & 7); pf[2] = *(const u32x4*)(up_); pf[3] = *(const u32x4*)(up_ + 8 * 3072); } while (0)
            if (!have) SGU_LOAD(R0);
            const u32x4 cv0 = pf[0], cv1 = pf[1], cu0 = pf[2], cu1 = pf[3];
            if (pre) SGU_LOAD(R0n);
            have = pre;
#undef SGU_LOAD
            {
                float v[16]; { float t0[8], t1[8]; pg8::unpack8(cv0, t0); pg8::unpack8(cv1, t1);
#pragma unroll
                    for (int e = 0; e < 8; ++e) { v[e] = t0[e]; v[8 + e] = t1[e]; } }
                float s = 0.f;
#pragma unroll
                for (int e = 0; e < 16; ++e) s += v[e];
                s += __shfl_xor(s, 1); s += __shfl_xor(s, 2);
                const float mu = s * (1.0f / 64.0f); float s2 = 0.f;
#pragma unroll
                for (int e = 0; e < 16; ++e) { v[e] -= mu; s2 += v[e] * v[e]; }
                s2 += __shfl_xor(s2, 1); s2 += __shfl_xor(s2, 2);
                const float rstd = rsqrtf(s2 * (1.0f / 64.0f) + 1e-6f);
#pragma unroll
                for (int e = 0; e < 16; ++e) Tl[(ch0 + e) * 136 + vrow] = (bf16)(pk2(v[e] * rstd * Fl[128 + ch0 + e], 0.f) & 0xffffu);
            }
            LDS_BAR();
            f32x4 acc[4];
#pragma unroll
            for (int ct = 0; ct < 4; ++ct) acc[ct] = (f32x4){0.f, 0.f, 0.f, 0.f};
#pragma unroll
            for (int ks = 0; ks < 4; ++ks) {
                const bf16x8 bfr = *(const LAS bf16x8*)(Wl + (16 * wid + r16) * 136 + 32 * ks + 8 * q);
#pragma unroll
                for (int ct = 0; ct < 4; ++ct) { const bf16x8 afr = *(const LAS bf16x8*)(Tl + (16 * ct + r16) * 136 + 32 * ks + 8 * q);
                    acc[ct] = __builtin_amdgcn_mfma_f32_16x16x32_bf16(afr, bfr, acc[ct], 0, 0, 0); }
            }
            {
                LAS float* Sl = (LAS float*)Zl;
                const float bias = Fl[ui];
#pragma unroll
                for (int ct = 0; ct < 4; ++ct) *(LAS f32x4*)(Sl + ui * 68 + 16 * ct + 4 * q) = acc[ct] + bias;
                asm volatile("s_waitcnt lgkmcnt(0)" ::: "memory");
#pragma unroll
                for (int k = 0; k < 2; ++k) { const int i = 16 * wid + (lane >> 3) + 8 * k, c8 = 8 * (lane & 7);
                    const f32x4 s0 = *(const LAS f32x4*)(Sl + i * 68 + c8), s1 = *(const LAS f32x4*)(Sl + i * 68 + c8 + 4);
                    float uf[8]; pg8::unpack8(k == 0 ? cu0 : cu1, uf);
                    u32x4 o; o.x = pk2(uf[0] * s0[0], uf[1] * s0[1]); o.y = pk2(uf[2] * s0[2], uf[3] * s0[3]); o.z = pk2(uf[4] * s1[0], uf[5] * s1[1]); o.w = pk2(uf[6] * s1[2], uf[7] * s1[3]);
                    *(u32x4*)(Y + (size_t)(R0 + i) * 1536 + g * 64 + c8) = o; }
            }
            LDS_BAR();
        } else if (job < 12) {
            const int c0 = 128 * (job - 8) + 8 * (tid & 15), gr0 = R0 + 4 * (tid >> 4), tb0 = gr0 & (SEQ - 1);
            const float* cw = a.in[I_CBW] + (size_t)l * 3 * 512 + c0;
            float w0[8], w1[8], w2[8];
            { const f32x4 a0 = *(const f32x4*)(cw), a1 = *(const f32x4*)(cw + 4), b0 = *(const f32x4*)(cw + 512), b1 = *(const f32x4*)(cw + 516), d0 = *(const f32x4*)(cw + 1024), d1 = *(const f32x4*)(cw + 1028);
#pragma unroll
              for (int e = 0; e < 4; ++e) { w0[e] = a0[e]; w0[4 + e] = a1[e]; w1[e] = b0[e]; w1[4 + e] = b1[e]; w2[e] = d0[e]; w2[4 + e] = d1[e]; } }
            float z2[8], z1[8];
#pragma unroll
            for (int e = 0; e < 8; ++e) { z2[e] = 0.f; z1[e] = 0.f; }
            if (tb0 >= 2) { float cgv[8], xv[8]; const bf16* p = PA + (size_t)(gr0 - 2) * 3072 + c0; pg8::unpack8(*(const u32x4*)(p + 1536), cgv); pg8::unpack8(*(const u32x4*)(p + 2048), xv);
#pragma unroll
                for (int e = 0; e < 8; ++e) z2[e] = cgv[e] * xv[e]; }
            if (tb0 >= 1) { float cgv[8], xv[8]; const bf16* p = PA + (size_t)(gr0 - 1) * 3072 + c0; pg8::unpack8(*(const u32x4*)(p + 1536), cgv); pg8::unpack8(*(const u32x4*)(p + 2048), xv);
#pragma unroll
                for (int e = 0; e < 8; ++e) z1[e] = cgv[e] * xv[e]; }
#pragma unroll
            for (int rr = 0; rr < 4; ++rr) {
                const bf16* p = PA + (size_t)(gr0 + rr) * 3072 + c0; float bgv[8], cgv[8], xv[8], o[8];
                pg8::unpack8(*(const u32x4*)(p + 1024), bgv); pg8::unpack8(*(const u32x4*)(p + 1536), cgv); pg8::unpack8(*(const u32x4*)(p + 2048), xv);
#pragma unroll
                for (int e = 0; e < 8; ++e) { const float z0 = cgv[e] * xv[e]; o[e] = bgv[e] * (w0[e] * z2[e] + w1[e] * z1[e] + w2[e] * z0); z2[e] = z1[e]; z1[e] = z0; }
                u32x4 w; w.x = pk2(o[0], o[1]); w.y = pk2(o[2], o[3]); w.z = pk2(o[4], o[5]); w.w = pk2(o[6], o[7]);
                *(u32x4*)(Y + (size_t)(gr0 + rr) * 1536 + 512 + c0) = w;
            }
        } else {
            const int g = job - 12, win = 2 << g, c0 = 8 * (tid & 15), rl0 = 4 * (tid >> 4), tb0 = (R0 + rl0) & (SEQ - 1);
            const bf16* zc = PA + 2560 + 128 * g;
#define POOL_LOAD(R) do { const int tbb_ = ((R) & (SEQ - 1)) - 15; _Pragma("unroll") for (int k = 0; k < 5; ++k) { const int idx_ = tid + 512 * k, row_ = idx_ >> 4, ch_ = idx_ & 15; \
                pf[k] = (idx_ < 2288 && tbb_ + row_ >= 0) ? *(const u32x4*)(zc + (size_t)((R) - 15 + row_) * 3072 + 8 * ch_) : (u32x4){0u, 0u, 0u, 0u}; } } while (0)
            if (!have) POOL_LOAD(R0);
#pragma unroll
            for (int k = 0; k < 5; ++k) { const int idx = tid + 512 * k, row = idx >> 4, ch = idx & 15; if (idx < 2288) *(LAS u32x4*)(Zl + row * 136 + 8 * ch) = pf[k]; }
            if (pre) POOL_LOAD(R0n);
            have = pre;
#undef POOL_LOAD
            LDS_BAR();
            float S[8];
#pragma unroll
            for (int e = 0; e < 8; ++e) S[e] = 0.f;
#pragma unroll
            for (int d = 15; d >= 1; --d) { if (d < win) { float z[8]; pg8::unpack8(*(const LAS u32x4*)(Zl + (15 + rl0 - d) * 136 + c0), z);
#pragma unroll
                for (int e = 0; e < 8; ++e) S[e] += z[e]; } }
#pragma unroll
            for (int rr = 0; rr < 4; ++rr) {
                float z[8]; pg8::unpack8(*(const LAS u32x4*)(Zl + (15 + rl0 + rr) * 136 + c0), z);
#pragma unroll
                for (int e = 0; e < 8; ++e) S[e] += z[e];
                if (rr > 0) { float zo[8]; pg8::unpack8(*(const LAS u32x4*)(Zl + (15 + rl0 + rr - win) * 136 + c0), zo);
#pragma unroll
                    for (int e = 0; e < 8; ++e) S[e] -= zo[e]; }
                const int tb = tb0 + rr; const float inv = 1.0f / (float)((tb + 1) < win ? (tb + 1) : win); float o[8];
#pragma unroll
                for (int e = 0; e < 8; ++e) o[e] = S[e] * inv - z[e];
                u32x4 w; w.x = pk2(o[0], o[1]); w.y = pk2(o[2], o[3]); w.z = pk2(o[4], o[5]); w.w = pk2(o[6], o[7]);
                *(LAS u32x4*)(Tl + (rl0 + rr) * 136 + c0) = w;
            }
            LDS_BAR();
            f32x4 acc[8];
#pragma unroll
            for (int dt = 0; dt < 8; ++dt) acc[dt] = (f32x4){0.f, 0.f, 0.f, 0.f};
#pragma unroll
            for (int ks = 0; ks < 4; ++ks) {
                const bf16x8 bfr = *(const LAS bf16x8*)(Tl + (16 * wid + r16) * 136 + 32 * ks + 8 * q);
#pragma unroll
                for (int dt = 0; dt < 8; ++dt) { const bf16x8 afr = *(const LAS bf16x8*)(Wl + (16 * dt + r16) * 136 + 32 * ks + 8 * q);
                    acc[dt] = __builtin_amdgcn_mfma_f32_16x16x32_bf16(afr, bfr, acc[dt], 0, 0, 0); }
            }
            {
                const int t = 16 * wid + r16;
#pragma unroll
                for (int dt = 0; dt < 8; ++dt) { const int d0 = 16 * dt + 4 * q; const f32x4 sc = *(const LAS f32x4*)(Fl + d0);
                    u32x2 o; o.x = pk2(acc[dt][0] * sc[0], acc[dt][1] * sc[1]); o.y = pk2(acc[dt][2] * sc[2], acc[dt][3] * sc[3]);
                    *(LAS u32x2*)(Tl + t * 136 + d0) = o; }
                asm volatile("s_waitcnt lgkmcnt(0)" ::: "memory");
#pragma unroll
                for (int k = 0; k < 4; ++k) { const int row = 16 * wid + (lane >> 4) + 4 * k, ch = lane & 15;
                    *(u32x4*)(Y + (size_t)(R0 + row) * 1536 + 1024 + 128 * g + 8 * ch) = *(const LAS u32x4*)(Tl + row * 136 + 8 * ch); }
            }
            LDS_BAR();
        }
    }
}

__device__ __forceinline__ void ffn_conv_phase(const Args& a, int l, int half) {
    const bf16* AP = (const bf16*)(a.ws + WS_AP); bf16* ACT = (bf16*)(a.ws + WS_ACT);
    const int gtid = blockIdx.x * 512 + tid_l(), nth = gridDim.x * 512;
    for (int it = gtid; it < 1024 * 11 * 16; it += nth) {
        const int chg = it & 15, tmp = it >> 4, n = tmp % 11, rc = tmp / 11;
        const int jg = 128 * (n + 11 * half) + 8 * chg, cb = 256 * n + 8 * chg, gr0 = 16 * rc, tb0 = gr0 & (SEQ - 1);
        const float* cw = a.in[I_FCW] + (size_t)l * 3 * UPC + jg;
        float wg[3][8], wv[3][8];
#pragma unroll
        for (int k = 0; k < 3; ++k) { const f32x4 g0 = *(const f32x4*)(cw + k * UPC), g1 = *(const f32x4*)(cw + k * UPC + 4), v0 = *(const f32x4*)(cw + k * UPC + DFF), v1 = *(const f32x4*)(cw + k * UPC + DFF + 4);
#pragma unroll
            for (int e = 0; e < 4; ++e) { wg[k][e] = g0[e]; wg[k][4 + e] = g1[e]; wv[k][e] = v0[e]; wv[k][4 + e] = v1[e]; } }
        float g2[8], g1[8], v2[8], v1[8];
#pragma unroll
        for (int e = 0; e < 8; ++e) { g2[e] = 0.f; g1[e] = 0.f; v2[e] = 0.f; v1[e] = 0.f; }
        if (tb0 >= 2) { const bf16* p = AP + (size_t)(gr0 - 2) * DFF + cb; pg8::unpack8(*(const u32x4*)p, g2); pg8::unpack8(*(const u32x4*)(p + 128), v2); }
        if (tb0 >= 1) { const bf16* p = AP + (size_t)(gr0 - 1) * DFF + cb; pg8::unpack8(*(const u32x4*)p, g1); pg8::unpack8(*(const u32x4*)(p + 128), v1); }
#pragma unroll 4
        for (int rr = 0; rr < 16; ++rr) {
            const bf16* p = AP + (size_t)(gr0 + rr) * DFF + cb; float g0[8], v0[8], o[8];
            pg8::unpack8(*(const u32x4*)p, g0); pg8::unpack8(*(const u32x4*)(p + 128), v0);
#pragma unroll
            for (int e = 0; e < 8; ++e) {
                const float ag = wg[0][e] * g2[e] + wg[1][e] * g1[e] + wg[2][e] * g0[e], av = wv[0][e] * v2[e] + wv[1][e] * v1[e] + wv[2][e] * v0[e];
                o[e] = ag * __builtin_amdgcn_rcpf(1.0f + __expf(-ag)) * av;
                g2[e] = g1[e]; g1[e] = g0[e]; v2[e] = v1[e]; v1[e] = v0[e]; }
            u32x4 w; w.x = pk2(o[0], o[1]); w.y = pk2(o[2], o[3]); w.z = pk2(o[4], o[5]); w.w = pk2(o[6], o[7]);
            *(u32x4*)(ACT + (size_t)(gr0 + rr) * DFF + jg) = w;
        }
    }
}

__device__ __forceinline__ void final_norm(const Args& a) {
    const int tidl = tid_l(), lane = tidl & 63, gw = blockIdx.x * 8 + (tidl >> 6), NGW = gridDim.x * 8;
    const f32x4* gp = (const f32x4*)a.in[I_NF] + lane;
    for (int m = gw; m < M; m += NGW) {
        f32x4* xr = (f32x4*)(a.out + (size_t)m * DM) + lane; f32x4 v[4]; float s = 0.f;
#pragma unroll
        for (int j = 0; j < 4; ++j) { v[j] = xr[64 * j]; s += (v[j][0] * v[j][0] + v[j][1] * v[j][1]) + (v[j][2] * v[j][2] + v[j][3] * v[j][3]); }
        const float rs = rsqrtf(wave_sum(s) * (1.0f / 1024.0f) + 1e-6f);
#pragma unroll
        for (int j = 0; j < 4; ++j) xr[64 * j] = v[j] * rs * gp[64 * j];
    }
}

#define XB_TMO      128
#define XB_XCNT(j)  (256  + 64 * (j))
#define XB_XSUB(j)  (1280 + 64 * (j))
#define XB_XGEN(j)  (2304 + 64 * (j))
#define XB_TOP      3328
#define XB_TOPGEN   3392
#define XCD_BAR_WORDS 3456
#define XB_SPIN_CAP (1u << 18)

__device__ __forceinline__ unsigned xb_ld(unsigned* p)              { return __hip_atomic_load(p, __ATOMIC_RELAXED, __HIP_MEMORY_SCOPE_AGENT); }
__device__ __forceinline__ unsigned xb_add(unsigned* p, unsigned v) { return __hip_atomic_fetch_add(p, v, __ATOMIC_RELAXED, __HIP_MEMORY_SCOPE_AGENT); }
__device__ __forceinline__ unsigned xb_xcc_id() { return (unsigned)__builtin_amdgcn_s_getreg((3 << 11) | 20) & 0xFu; }
#define XB_SPIN(cond, bar) do { unsigned _sp = 0; while (cond) { __builtin_amdgcn_s_sleep(1); \
    if ((++_sp & 255u) == 0u) { if (xb_ld(&(bar)[XB_TMO])) break; if (_sp > XB_SPIN_CAP) { atomicAdd(&(bar)[XB_TMO], 1u); break; } } } } while (0)

struct XcdBarrier {
    unsigned* bar; unsigned x;
    volatile LAS unsigned* st;
};

__device__ __forceinline__ XcdBarrier xcd_barrier_post(unsigned* bar, volatile LAS unsigned* st) {
    XcdBarrier b; b.bar = bar; b.x = xb_xcc_id(); b.st = st;
    if (threadIdx.x == 0) (void)xb_add(&bar[XB_XCNT(b.x)], 1u);
    return b;
}
__device__ __forceinline__ void xcd_barrier_complete(unsigned* bar, unsigned x, unsigned& nloc, unsigned& nx) {
    const unsigned G = gridDim.x * gridDim.y * gridDim.z;
    unsigned sum, cnt, mine, sp = 0u;
    for (;;) {
        sum = 0u; cnt = 0u; mine = 0u;
#pragma unroll
        for (unsigned j = 0; j < 16; ++j) { const unsigned c = xb_ld(&bar[XB_XCNT(j)]); sum += c; cnt += (c > 0u) ? 1u : 0u; mine = (j == x) ? c : mine; }
        if (sum == G) break;
        __builtin_amdgcn_s_sleep(1);
        if ((++sp & 255u) == 0u) { if (xb_ld(&bar[XB_TMO])) break; if (sp > XB_SPIN_CAP) { atomicAdd(&bar[XB_TMO], 1u); break; } }
    }
    nloc = mine > 0u ? mine : 1u; nx = cnt > 0u ? cnt : 1u;
}

__device__ __forceinline__ void xcd_barrier(const XcdBarrier& b) {
    asm volatile("s_waitcnt vmcnt(0)" ::: "memory");
    __syncthreads();
    if (threadIdx.x == 0) {
        unsigned* bar = b.bar;
        __builtin_amdgcn_s_waitcnt(0);
        unsigned nloc = b.st[0], nx = b.st[1];
        if (nloc == 0u) { xcd_barrier_complete(bar, b.x, nloc, nx); b.st[0] = nloc; b.st[1] = nx; }
        const unsigned old = xb_add(&bar[XB_XSUB(b.x)], 1u);
        const unsigned gen = old / nloc;
        if (old + 1u == (gen + 1u) * nloc) {
            __builtin_amdgcn_fence(__ATOMIC_RELEASE, "agent");
            asm volatile("s_waitcnt vmcnt(0)" ::: "memory");
            const unsigned og = xb_add(&bar[XB_TOP], 1u);
            const unsigned tg = og / nx;
            if (og + 1u == (tg + 1u) * nx) xb_add(&bar[XB_TOPGEN], 1u);
            else XB_SPIN(xb_ld(&bar[XB_TOPGEN]) == tg, bar);
            __builtin_amdgcn_fence(__ATOMIC_ACQUIRE, "agent");
            xb_add(&bar[XB_XGEN(b.x)], 1u);
            asm volatile("s_waitcnt vmcnt(0)" ::: "memory");
        } else {
            XB_SPIN(xb_ld(&bar[XB_XGEN(b.x)]) == gen, bar);
            __builtin_amdgcn_fence(__ATOMIC_ACQUIRE, "agent");
            asm volatile("s_waitcnt vmcnt(0)" ::: "memory");
        }
    }
    __syncthreads();
}

__global__ void __launch_bounds__(512, 2) fwd_kernel(Args a) {
    extern __shared__ __attribute__((aligned(16))) unsigned char lds_raw[];
    LAS unsigned char* lds = (LAS unsigned char*)lds_raw;
    cg::grid_group grid = cg::this_grid();
    const int G = gridDim.x, c = blockIdx.x;
    unsigned char* ws = a.ws;
    unsigned* barw = (unsigned*)(ws + WS_BAR);
    if (blockIdx.x == 0) for (int i = threadIdx.x; i < XCD_BAR_WORDS; i += 512) barw[i] = 0u;
    if (threadIdx.x < 2) ((volatile LAS unsigned*)(lds + LDS_ST))[threadIdx.x] = 0u;
    grid.sync();
    const XcdBarrier bar = xcd_barrier_post(barw, (volatile LAS unsigned*)(lds + LDS_ST));
    float* slots = (float*)(ws + WS_SLOTS);
    bf16* XB = (bf16*)(ws + WS_XB);
#pragma unroll 1
    for (int l = 0; l < DEPTH; ++l) {
#pragma unroll 1
        for (int ph = 0; ph < 11; ++ph) {
            if (ph == 0) { if (l != 0) continue;
                convert_items(lds, a, 0, 0, CI_ALL, c * 8 + (tid_l() >> 6), G * 8); xprep_phase(a); }
            else if (ph == 7 || ph == 8 || ph == 9) continue;
            else if (ph == 6) {
                pg8::Gemm g{XB, (const bf16*)(ws + (l == 0 ? WS_WUP : WS_WUP1)), DM, DM, DM};
                pg8::SchedConv S{G, c};
                pg8::EpiConv E{(bf16*)(ws + WS_ACT), slots, a.in[I_FCW] + (size_t)l * 3 * UPC, (LAS float*)(lds + 131072)};
                pg8::gemm_phase<pg8::EpiConv, pg8::SchedConv, true, true>(lds, g, S, E);
                if (l + 1 < DEPTH) {
                    const bool idle = (G == 256); const int wv = tid_l() >> 6;
                    if (!idle || c >= 150) convert_items(lds, a, l + 1, 0, CI_B, idle ? (c - 150) * 8 + wv : c * 8 + wv, idle ? 106 * 8 : G * 8);
                }
            }
            else if (ph == 1) {
                const bf16* Bt = (const bf16*)(ws + WS_WIN) + (size_t)0 * DM;
                pg8::Gemm g{XB, Bt, DM, DM, DM};
                pg8::SchedPlain S{M / 256, 3072 / 256, G, c, (size_t)256 * DM * 2, (size_t)256 * DM * 2};
                pg8::EpiAct E{(bf16*)(ws + WS_PA), 3072, slots, 0, (LAS float*)(lds + 131072)};
                pg8::gemm_phase<pg8::EpiAct, pg8::SchedPlain, true, true>(lds, g, S, E);
            }
            else if (ph == 3) {
                const bf16* Bt = (const bf16*)(ws + WS_WIN) + (size_t)3072 * DM;
                pg8::Gemm g{XB, Bt, DM, DM, DM};
                pg8::SchedPlain S{M / 256, 3072 / 256, G, c, (size_t)256 * DM * 2, (size_t)256 * DM * 2};
                pg8::EpiAct E{(bf16*)(ws + WS_PA), 3072, slots, 1, (LAS float*)(lds + 131072)};
                pg8::gemm_phase<pg8::EpiAct, pg8::SchedPlain, true, true>(lds, g, S, E);
            }
            else if (ph == 2) mixer_phase(lds, a, l);
            else if (ph == 4) {
                pg8::Gemm g{(const bf16*)(ws + WS_Y), (const bf16*)(ws + WS_WBR), 1536, 512, 512};
                pg8::SchedBranch S{M / 256, DM / 256, G, c};
                pg8::EpiGate E{(const bf16*)(ws + WS_PA), (bf16*)(ws + WS_MG)};
                pg8::gemm_phase<pg8::EpiGate, pg8::SchedBranch, true, true>(lds, g, S, E);
            }
            else if (ph == 5 || ph == 10) {
                const bool dn = ph == 10;
                pg8::Gemm g{dn ? (const bf16*)(ws + WS_ACT) : (const bf16*)(ws + WS_MG), dn ? (const bf16*)(ws + (l == 0 ? WS_WDN : WS_WDN1)) : (const bf16*)(ws + WS_WO), dn ? DFF : DM, dn ? DFF : DM, dn ? DFF : DM};
                pg8::SchedPlain S{M / 256, DM / 256, G, c, (size_t)256 * (dn ? DFF : DM) * 2, (size_t)256 * (dn ? DFF : DM) * 2};
                pg8::EpiRes E{(l == 0 && !dn) ? a.in[I_X] : (const float*)a.out, a.out, XB, slots};
                pg8::gemm_phase<pg8::EpiRes, pg8::SchedPlain, true, true>(lds, g, S, E);
                if (dn && l + 1 < DEPTH) convert_items(lds, a, l + 1, CI_B, CI_ALL, c * 8 + (tid_l() >> 6), G * 8);
            }
            xcd_barrier(bar);
        }
    }
    final_norm(a);
}

extern "C" void kernel_launch(void* const* d_in, const int* in_sizes, int n_in, void* d_out, int out_size, void* d_ws, size_t ws_size, hipStream_t stream) {
    static int grid = 0;
    if (grid == 0) {
        if (n_in != 18 || out_size != M * DM || ws_size < WS_END) { fprintf(stderr, "kernel_launch: unexpected shapes (n_in %d, out %d, ws %zu)\n", n_in, out_size, ws_size); grid = -1; return; }
        int dev = 0, cus = 0, per_cu = 0;
        hipGetDevice(&dev); hipDeviceGetAttribute(&cus, hipDeviceAttributeMultiprocessorCount, dev);
        if (hipFuncSetAttribute((const void*)fwd_kernel, hipFuncAttributeMaxDynamicSharedMemorySize, LDS_BYTES) != hipSuccess) { fprintf(stderr, "kernel_launch: hipFuncSetAttribute failed\n"); grid = -1; return; }
        if (hipOccupancyMaxActiveBlocksPerMultiprocessor(&per_cu, (const void*)fwd_kernel, 512, LDS_BYTES) != hipSuccess || per_cu < 1) { fprintf(stderr, "kernel_launch: occupancy query failed (%d)\n", per_cu); grid = -1; return; }
        grid = cus;
    }
    if (grid < 0) return;
    Args a{};
    for (int i = 0; i < 18; ++i) a.in[i] = (const float*)d_in[i];
    a.out = (float*)d_out; a.ws = (unsigned char*)d_ws;
    void* args[] = {&a};
    hipError_t e = hipLaunchCooperativeKernel((const void*)fwd_kernel, dim3(grid), dim3(512), args, LDS_BYTES, stream);
    if (e != hipSuccess) fprintf(stderr, "kernel_launch: cooperative launch failed: %s (grid %d)\n", hipGetErrorString(e), grid);
}
```

```cpp
#include <hip/hip_runtime.h>
#include <hip/hip_cooperative_groups.h>
#include <cstdio>
#include <cstdint>
namespace cg = cooperative_groups;

namespace pg8 {
#define PG8_LAS __attribute__((address_space(3)))
typedef unsigned short bf16_t;
typedef short bf16x8 __attribute__((ext_vector_type(8)));
typedef float f32x4 __attribute__((ext_vector_type(4)));
typedef unsigned u32x4 __attribute__((ext_vector_type(4)));
typedef unsigned u32x2 __attribute__((ext_vector_type(2)));
constexpr int BM = 256, BK = 64, HALF = 128, HTB = HALF * BK * 2  , STAGE_BYTES = 8 * HTB, NXCD = 8, WGM = 8;

__host__ __device__ __forceinline__ int lds_byte(int r, int c) { const int st = (r >> 4) * 2 + (c >> 5), rr = r & 15, cc = c & 31, ob = rr * 64 + cc * 2; return st * 1024 + (ob ^ (((ob >> 9) & 1) << 5)); }
__host__ __device__ __forceinline__ void stage_rc(int b, int& R, int& C) { const int st = b / 1024, sb = b % 1024, swz = sb ^ (((sb >> 9) & 1) << 5); R = (st >> 1) * 16 + swz / 64; C = (st & 1) * 32 + (swz % 64) / 2; }
__host__ __device__ __forceinline__ int perm32(int rho) { const int n = rho >> 4, i = rho & 15; return 8 * (i >> 2) + 4 * n + (i & 3); }

struct Unit { int pm, pn, sub; size_t aoff, boff; };
struct Gemm { const bf16_t* A; const bf16_t* Bt; int lda, ldb, K; };

__device__ __forceinline__ unsigned cvt_pk_bf16(float lo, float hi) { unsigned r; asm volatile("s_nop 0\n\tv_cvt_pk_bf16_f32 %0, %1, %2" : "=v"(r) : "v"(lo), "v"(hi)); return r; }
typedef float f32x2 __attribute__((ext_vector_type(2)));
__device__ __forceinline__ f32x2 gelu_pk(f32x2 v) {
    const f32x2 av = __builtin_elementwise_abs(v), d = av * 0.2316418882f + 1.0f;
    f32x2 t; t.x = __builtin_amdgcn_rcpf(d.x); t.y = __builtin_amdgcn_rcpf(d.y);
    f32x2 q = t * 0.5307027145f + (-0.7265760135f); q = q * t + 0.7107068705f; q = q * t + (-0.142248368f); q = q * t + 0.127414796f; q = q * t;
    const f32x2 s = (v * v) * (-0.72134752044f);
    f32x2 e; e.x = __builtin_amdgcn_exp2f(s.x); e.y = __builtin_amdgcn_exp2f(s.y);
    const f32x2 m = v * (q * e), r = v - m;
    f32x2 o; o.x = v.x < 0.f ? m.x : r.x; o.y = v.y < 0.f ? m.y : r.y; return o;
}

template <class Epi, class Sched, bool ALIGN_EPI = false, bool SP2 = false>
__device__ __forceinline__ void gemm_phase(PG8_LAS unsigned char* lds, const Gemm g, const Sched& S, const Epi& E) {
    int tid_ = threadIdx.x; asm volatile("" : "+v"(tid_));
    const int tid = tid_, wid = __builtin_amdgcn_readfirstlane(tid >> 6), lane = tid & 63, wr = wid >> 2, wc = wid & 3, fr = lane & 15, fq = lane >> 4;
    const int K = g.K, nt = K / BK;
    unsigned voffA[2], voffB[2];
#pragma unroll
    for (int i = 0; i < 2; ++i) { int R, C; stage_rc(tid * 16 + i * 8192, R, C); const int Rb = Epi::PERM ? ((R & ~31) + perm32(R & 31)) : R;
        voffA[i] = (unsigned)(R * g.lda + C) * 2u; voffB[i] = (unsigned)(Rb * g.ldb + C) * 2u; }
    const size_t kstep = (size_t)(BK * 2);
    const size_t hstepA = (size_t)HALF * g.lda * 2, hstepB = (size_t)HALF * g.ldb * 2;
    const unsigned ldsw = (unsigned)wid * 1024u;
    const int aoff = lds_byte(wr * 64 + fr, fq * 8), boff = lds_byte(wc * 32 + fr, fq * 8);
#define PG8_SA(b, h) (((b) * 2 + (h)) * HTB)
#define PG8_SB(b, h) ((4 + (b) * 2 + (h)) * HTB)
#define PG8_STAGE(bufoff, gbase, voff) do { _Pragma("unroll") for (int _i = 0; _i < 2; ++_i) \
        __builtin_amdgcn_global_load_lds((const unsigned*)((const char*)(gbase) + (voff)[_i]), (PG8_LAS unsigned*)(lds + (bufoff) + ldsw + _i * 8192), 16, 0, 0); } while (0)
#define PG8_LDA(dst, b, h) do { _Pragma("unroll") for (int m = 0; m < 4; ++m) _Pragma("unroll") for (int k = 0; k < 2; ++k) dst[m][k] = *(const PG8_LAS bf16x8*)(lds + PG8_SA(b, h) + aoff + m * 2048 + k * 1024); } while (0)
#define PG8_LDB(dst, b, h) do { _Pragma("unroll") for (int n = 0; n < 2; ++n) _Pragma("unroll") for (int k = 0; k < 2; ++k) dst[n][k] = *(const PG8_LAS bf16x8*)(lds + PG8_SB(b, h) + boff + n * 2048 + k * 1024); } while (0)
#define PG8_MMA(ai, bj, At, Bt) do { __builtin_amdgcn_s_setprio(1); _Pragma("unroll") for (int m = 0; m < 4; ++m) _Pragma("unroll") for (int n = 0; n < 2; ++n) _Pragma("unroll") for (int k = 0; k < 2; ++k) \
        acc[ai][bj][m][n] = __builtin_amdgcn_mfma_f32_16x16x32_bf16(Bt[n][k], At[m][k], acc[ai][bj][m][n], 0, 0, 0); __builtin_amdgcn_s_setprio(0); } while (0)
#define PG8_WAIT_V(n) asm volatile("s_waitcnt vmcnt(" #n ")" ::: "memory")
#define PG8_WAIT_L(n) asm volatile("s_waitcnt lgkmcnt(" #n ")" ::: "memory")
#define PG8_BAR __builtin_amdgcn_s_barrier()
#define PG8_SCHED __builtin_amdgcn_sched_barrier(0)
    Unit cur, nxt; int ui = 0;
    if (!S.next(0, cur)) return;
    f32x4 acc[2][2][4][2];
#pragma unroll
    for (int a = 0; a < 2; ++a)
#pragma unroll
        for (int b = 0; b < 2; ++b)
#pragma unroll
            for (int m = 0; m < 4; ++m)
#pragma unroll
                for (int n = 0; n < 2; ++n) acc[a][b][m][n] = (f32x4){0.f, 0.f, 0.f, 0.f};
    bf16x8 At[4][2], B0[2][2], B1[2][2];
    const char* cA = (const char*)g.A + cur.aoff; const char* cB = (const char*)g.Bt + cur.boff;
    if constexpr (SP2) {
        PG8_STAGE(PG8_SB(0, 0), cB, voffB); PG8_STAGE(PG8_SB(0, 1), cB + hstepB, voffB); PG8_STAGE(PG8_SA(0, 0), cA, voffA); PG8_STAGE(PG8_SA(0, 1), cA + hstepA, voffA);
        if (wr == 1) PG8_BAR;
        PG8_WAIT_V(2); PG8_BAR;
        PG8_STAGE(PG8_SB(1, 0), cB + kstep, voffB); PG8_STAGE(PG8_SA(1, 0), cA + kstep, voffA); PG8_STAGE(PG8_SB(1, 1), cB + hstepB + kstep, voffB);
        PG8_WAIT_V(6); PG8_BAR;
    } else {
        PG8_STAGE(PG8_SB(0, 0), cB, voffB); PG8_STAGE(PG8_SA(0, 0), cA, voffA); PG8_STAGE(PG8_SB(0, 1), cB + hstepB, voffB); PG8_STAGE(PG8_SA(0, 1), cA + hstepA, voffA);
        if (wr == 1) PG8_BAR;
        PG8_WAIT_V(4); PG8_BAR;
        PG8_STAGE(PG8_SB(1, 0), cB + kstep, voffB); PG8_STAGE(PG8_SA(1, 0), cA + kstep, voffA); PG8_STAGE(PG8_SB(1, 1), cB + hstepB + kstep, voffB);
        PG8_WAIT_V(6); PG8_BAR;
    }
    for (;;) {
        const bool has_next = S.next(ui + 1, nxt);
        const char* nA = has_next ? (const char*)g.A + nxt.aoff : cA; const char* nB = has_next ? (const char*)g.Bt + nxt.boff : cB;
        for (int t = 0; t < nt; t += 2) {
            const bool last = (t == nt - 2);
            const char* a1 = cA + (size_t)(t + 1) * kstep;
            const char* a2 = last ? nA : cA + (size_t)(t + 2) * kstep; const char* b2 = last ? nB : cB + (size_t)(t + 2) * kstep;
            const char* a3 = a2 + kstep; const char* b3 = b2 + kstep;
            if constexpr (SP2) {
            PG8_LDB(B0, 0, 0); PG8_LDB(B1, 0, 1); PG8_SCHED; PG8_LDA(At, 0, 0); PG8_STAGE(PG8_SA(1, 1), a1 + hstepA, voffA);
            PG8_WAIT_V(8); PG8_WAIT_L(0); PG8_BAR; PG8_MMA(0, 0, At, B0); PG8_MMA(0, 1, At, B1); PG8_BAR; PG8_SCHED;
            PG8_LDA(At, 0, 1); PG8_STAGE(PG8_SB(0, 0), b2, voffB); PG8_STAGE(PG8_SB(0, 1), b2 + hstepB, voffB); PG8_STAGE(PG8_SA(0, 0), a2, voffA);
            PG8_WAIT_V(8); PG8_WAIT_L(0); PG8_BAR; PG8_MMA(1, 0, At, B0); PG8_MMA(1, 1, At, B1); PG8_BAR; PG8_SCHED;
            PG8_LDB(B0, 1, 0); PG8_LDB(B1, 1, 1); PG8_SCHED; PG8_LDA(At, 1, 0); PG8_STAGE(PG8_SA(0, 1), a2 + hstepA, voffA);
            PG8_WAIT_V(8); PG8_WAIT_L(0); PG8_BAR; PG8_MMA(0, 0, At, B0); PG8_MMA(0, 1, At, B1); PG8_BAR; PG8_SCHED;
            PG8_LDA(At, 1, 1); PG8_STAGE(PG8_SB(1, 0), b3, voffB); PG8_STAGE(PG8_SB(1, 1), b3 + hstepB, voffB); PG8_STAGE(PG8_SA(1, 0), a3, voffA);
            PG8_WAIT_V(8); PG8_WAIT_L(0); PG8_BAR; PG8_MMA(1, 0, At, B0); PG8_MMA(1, 1, At, B1); PG8_BAR; PG8_SCHED;
            } else {
            PG8_LDB(B0, 0, 0); PG8_SCHED; PG8_LDA(At, 0, 0); PG8_STAGE(PG8_SA(1, 1), a1 + hstepA, voffA);
            PG8_WAIT_L(8); PG8_BAR; PG8_WAIT_L(0); PG8_MMA(0, 0, At, B0); PG8_BAR; PG8_SCHED;
            PG8_LDB(B1, 0, 1); PG8_STAGE(PG8_SB(0, 0), b2, voffB);
            PG8_BAR; PG8_WAIT_L(0); PG8_MMA(0, 1, At, B1); PG8_BAR;
            PG8_LDA(At, 0, 1); PG8_STAGE(PG8_SA(0, 0), a2, voffA);
            PG8_BAR; PG8_WAIT_L(0); PG8_MMA(1, 0, At, B0); PG8_BAR; PG8_SCHED;
            PG8_STAGE(PG8_SB(0, 1), b2 + hstepB, voffB);
            PG8_WAIT_V(6); PG8_BAR; PG8_MMA(1, 1, At, B1); PG8_BAR;
            PG8_LDB(B0, 1, 0); PG8_SCHED; PG8_LDA(At, 1, 0); PG8_STAGE(PG8_SA(0, 1), a2 + hstepA, voffA);
            PG8_WAIT_L(8); PG8_BAR; PG8_WAIT_L(0); PG8_MMA(0, 0, At, B0); PG8_BAR; PG8_SCHED;
            PG8_LDB(B1, 1, 1); PG8_STAGE(PG8_SB(1, 0), b3, voffB);
            PG8_BAR; PG8_WAIT_L(0); PG8_MMA(0, 1, At, B1); PG8_BAR;
            PG8_LDA(At, 1, 1); PG8_STAGE(PG8_SA(1, 0), a3, voffA);
            PG8_BAR; PG8_WAIT_L(0); PG8_MMA(1, 0, At, B0); PG8_BAR; PG8_SCHED;
            PG8_STAGE(PG8_SB(1, 1), b3 + hstepB, voffB);
            PG8_WAIT_V(6); PG8_BAR; PG8_MMA(1, 1, At, B1); PG8_BAR;
            }
        }
        if constexpr (ALIGN_EPI) { if (wr == 0) PG8_BAR; }
        E(acc, cur, wr, wc, fr, fq);
        if (!has_next) break;
        if (E.zero_after(cur)) {
#pragma unroll
        for (int a = 0; a < 2; ++a)
#pragma unroll
            for (int b = 0; b < 2; ++b)
#pragma unroll
                for (int m = 0; m < 4; ++m)
#pragma unroll
                    for (int n = 0; n < 2; ++n) acc[a][b][m][n] = (f32x4){0.f, 0.f, 0.f, 0.f};
        }
        cur = nxt; cA = nA; cB = nB; ++ui;
        if constexpr (ALIGN_EPI) { if (wr == 1) PG8_BAR; }
    }
    PG8_WAIT_V(0);
    if constexpr (!ALIGN_EPI) { if (wr == 0) PG8_BAR; }
    PG8_BAR;
#undef PG8_SA
#undef PG8_SB
#undef PG8_STAGE
#undef PG8_LDA
#undef PG8_LDB
#undef PG8_MMA
#undef PG8_WAIT_V
#undef PG8_WAIT_L
#undef PG8_BAR
#undef PG8_SCHED
}

__device__ __forceinline__ void tile_map(int L, int nM, int nN, int& pm, int& pn) {
    const int nwg = nM * nN; int wgid = L;
    { const int q = nwg / NXCD, r = nwg % NXCD, xcd = wgid % NXCD, off = wgid / NXCD; wgid = (xcd < r ? xcd * (q + 1) : r * (q + 1) + (xcd - r) * q) + off; }
    const int nig = WGM * nN, gid = wgid / nig, fm = gid * WGM, gsz = (nM - fm) < WGM ? (nM - fm) : WGM;
    pm = fm + ((wgid % nig) % gsz); pn = (wgid % nig) / gsz;
}
struct SchedPlain {
    int nM, nN, G, c; size_t astride, bstride;
    __device__ __forceinline__ bool next(int i, Unit& u) const {
        const long L = (long)i * G + c; if (L >= (long)nM * nN) return false;
        tile_map((int)L, nM, nN, u.pm, u.pn); u.sub = 0; u.aoff = (size_t)u.pm * astride; u.boff = (size_t)u.pn * bstride; return true;
    }
};
struct SchedBranch {
    int nM, nN, G, c;
    __device__ __forceinline__ bool next(int i, Unit& u) const {
        const int t = i / 3, s = i - 3 * t; const long L = (long)t * G + c; if (L >= (long)nM * nN) return false;
        tile_map((int)L, nM, nN, u.pm, u.pn); u.sub = s;
        u.aoff = (size_t)u.pm * (256 * 1536 * 2) + (size_t)s * (512 * 2); u.boff = ((size_t)s * 1024 + (size_t)u.pn * 256) * (512 * 2); return true;
    }
};

__device__ __forceinline__ float row_rstd(const float* slots, int row) {
    const f32x4* sp = (const f32x4*)(slots + (size_t)row * 16);
    const f32x4 s = (sp[0] + sp[1]) + (sp[2] + sp[3]);
    return rsqrtf(((s[0] + s[1]) + (s[2] + s[3])) * (1.0f / 1024.0f) + 1e-6f);
}
__device__ __forceinline__ float sigmoid_c(float z) { z = fminf(fmaxf(z, -30.f), 30.f); return __builtin_amdgcn_rcpf(1.0f + __expf(-z)); }

struct EpiAct {
    static constexpr bool PERM = true, AFTER_DRAIN = false;
    bf16_t* O; int ldc; const float* slots; int mode; PG8_LAS float* R;
    __device__ __forceinline__ bool zero_after(const Unit&) const { return true; }
    __device__ __forceinline__ void operator()(f32x4 (&acc)[2][2][4][2], const Unit& u, int wr, int wc, int fr_, int fq_) const {
        int fr = fr_, fq = fq_; asm volatile("" : "+v"(fr), "+v"(fq));
        { const int tl = (wr * 4 + wc) * 64 + fq * 16 + fr; if (tl < 256) R[tl] = row_rstd(slots, u.pm * BM + tl); }
        asm volatile("s_waitcnt vmcnt(0) lgkmcnt(0)" ::: "memory"); __builtin_amdgcn_s_barrier(); asm volatile("" ::: "memory");
        const int row0 = u.pm * BM + wr * 64 + fr, col0 = u.pn * BM + wc * 32 + 8 * fq;
        const int act = (mode == 1) ? 2 : ((mode == 0 && u.pn < 4) ? 1 : 0);
#pragma unroll
        for (int ai = 0; ai < 2; ++ai)
#pragma unroll
            for (int m = 0; m < 4; ++m) {
                const int row = row0 + ai * HALF + m * 16; const float rs = R[ai * HALF + wr * 64 + m * 16 + fr];
                bf16_t* rowp = O + (size_t)row * ldc + col0;
#pragma unroll
                for (int bj = 0; bj < 2; ++bj) {
                    f32x4 v0 = acc[ai][bj][m][0] * rs, v1 = acc[ai][bj][m][1] * rs;
                    if (act == 1) { f32x2 a = gelu_pk((f32x2){v0[0], v0[1]}), b = gelu_pk((f32x2){v0[2], v0[3]}), c = gelu_pk((f32x2){v1[0], v1[1]}), d = gelu_pk((f32x2){v1[2], v1[3]});
                        v0 = (f32x4){a.x, a.y, b.x, b.y}; v1 = (f32x4){c.x, c.y, d.x, d.y}; }
                    else if (act == 2) { v0 = (f32x4){sigmoid_c(v0[0]), sigmoid_c(v0[1]), sigmoid_c(v0[2]), sigmoid_c(v0[3])}; v1 = (f32x4){sigmoid_c(v1[0]), sigmoid_c(v1[1]), sigmoid_c(v1[2]), sigmoid_c(v1[3])}; }
                    u32x4 w; w.x = cvt_pk_bf16(v0[0], v0[1]); w.y = cvt_pk_bf16(v0[2], v0[3]); w.z = cvt_pk_bf16(v1[0], v1[1]); w.w = cvt_pk_bf16(v1[2], v1[3]);
                    *(u32x4*)(rowp + bj * HALF) = w; }
            }
    }
};
__device__ __forceinline__ void unpack8(const u32x4 v, float (&f)[8]) {
    f[0] = __uint_as_float(v.x << 16); f[1] = __uint_as_float(v.x & 0xffff0000u); f[2] = __uint_as_float(v.y << 16); f[3] = __uint_as_float(v.y & 0xffff0000u);
    f[4] = __uint_as_float(v.z << 16); f[5] = __uint_as_float(v.z & 0xffff0000u); f[6] = __uint_as_float(v.w << 16); f[7] = __uint_as_float(v.w & 0xffff0000u);
}
struct EpiGate {
    static constexpr bool PERM = true, AFTER_DRAIN = false;
    const bf16_t* Gt; bf16_t* O;
    __device__ __forceinline__ bool zero_after(const Unit& u) const { return u.sub == 2; }
    __device__ __forceinline__ void operator()(f32x4 (&acc)[2][2][4][2], const Unit& u, int wr, int wc, int fr_, int fq_) const {
        int fr = fr_, fq = fq_; asm volatile("" : "+v"(fr), "+v"(fq));
        const int row0 = u.pm * BM + wr * 64 + fr, col0 = u.pn * BM + wc * 32 + 8 * fq; const int s = u.sub;
        u32x4 ga[2][2], gb[2][2];
#define GATE_LOAD(st, g) do { const bf16_t* gp_ = Gt + (size_t)(row0 + ((g) >> 2) * HALF + ((g) & 3) * 16) * 3072 + s * 1024 + col0; \
            ga[st][0] = *(const u32x4*)(gp_); ga[st][1] = *(const u32x4*)(gp_ + HALF); \
            if (s < 2) { gb[st][0] = *(const u32x4*)(gp_ + 1024); gb[st][1] = *(const u32x4*)(gp_ + 1024 + HALF); } else { gb[st][0] = ga[st][0]; gb[st][1] = ga[st][1]; } } while (0)
        GATE_LOAD(0, 0);
#pragma unroll
        for (int g = 0; g < 8; ++g) {
            const int ai = g >> 2, m = g & 3, st = g & 1;
            if (g + 1 < 8) GATE_LOAD(st ^ 1, g + 1);
            __builtin_amdgcn_sched_barrier(0);
            const int row = row0 + ai * HALF + m * 16;
#pragma unroll
            for (int bj = 0; bj < 2; ++bj) {
                const int col = col0 + bj * HALF;
                float f[8]; unpack8(ga[st][bj], f);
                if (s < 2) { float h[8]; unpack8(gb[st][bj], h);
#pragma unroll
                    for (int e = 0; e < 8; ++e) f[e] *= __builtin_amdgcn_rcpf(h[e]); }
                f32x4 v0 = acc[ai][bj][m][0], v1 = acc[ai][bj][m][1];
                v0 = v0 * (f32x4){f[0], f[1], f[2], f[3]}; v1 = v1 * (f32x4){f[4], f[5], f[6], f[7]};
                acc[ai][bj][m][0] = v0; acc[ai][bj][m][1] = v1;
                if (s == 2) { u32x4 w; w.x = cvt_pk_bf16(v0[0], v0[1]); w.y = cvt_pk_bf16(v0[2], v0[3]); w.z = cvt_pk_bf16(v1[0], v1[1]); w.w = cvt_pk_bf16(v1[2], v1[3]);
                    *(u32x4*)(O + (size_t)row * 1024 + col) = w; }
            }
            __builtin_amdgcn_sched_barrier(0);
        }
#undef GATE_LOAD
        __builtin_amdgcn_s_waitcnt(0x0F70);
    }
};
struct EpiRes {
    static constexpr bool PERM = false, AFTER_DRAIN = false;
    bf16_t* XB; float* slots;
    __device__ __forceinline__ bool zero_after(const Unit&) const { return true; }
    __device__ __forceinline__ void operator()(f32x4 (&acc)[2][2][4][2], const Unit& u, int wr, int wc, int fr_, int fq_) const {
        int fr = fr_, fq = fq_; asm volatile("" : "+v"(fr), "+v"(fq));
        const int row0 = u.pm * BM + wr * 64 + fr, col0 = u.pn * BM + wc * 32 + 4 * fq;
        u32x2 xs[2][4];
#define RES_LOAD(st, g) do { const bf16_t* p_ = XB + (size_t)(row0 + ((g) >> 2) * HALF + ((g) & 3) * 16) * 1024 + col0; \
            xs[st][0] = *(const u32x2*)(p_); xs[st][1] = *(const u32x2*)(p_ + 16); xs[st][2] = *(const u32x2*)(p_ + HALF); xs[st][3] = *(const u32x2*)(p_ + HALF + 16); } while (0)
        RES_LOAD(0, 0);
#pragma unroll
        for (int g = 0; g < 8; ++g) {
            const int ai = g >> 2, m = g & 3, st = g & 1;
            if (g + 1 < 8) RES_LOAD(st ^ 1, g + 1);
            __builtin_amdgcn_sched_barrier(0);
            const int row = row0 + ai * HALF + m * 16; const size_t off = (size_t)row * 1024 + col0; float ss = 0.f;
#pragma unroll
            for (int bj = 0; bj < 2; ++bj)
#pragma unroll
                for (int n = 0; n < 2; ++n) {
                    const u32x2 xo = xs[st][bj * 2 + n];
                    const f32x4 xn = (f32x4){__uint_as_float(xo.x << 16), __uint_as_float(xo.x & 0xffff0000u), __uint_as_float(xo.y << 16), __uint_as_float(xo.y & 0xffff0000u)} + acc[ai][bj][m][n];
                    ss += (xn[0] * xn[0] + xn[1] * xn[1]) + (xn[2] * xn[2] + xn[3] * xn[3]);
                    u32x2 w; w.x = cvt_pk_bf16(xn[0], xn[1]); w.y = cvt_pk_bf16(xn[2], xn[3]);
                    *(u32x2*)(XB + off + bj * HALF + n * 16) = w; }
            ss += __shfl_xor(ss, 16); ss += __shfl_xor(ss, 32);
            if (fq == 0) slots[(size_t)row * 16 + u.pn * 4 + wc] = ss;
            __builtin_amdgcn_sched_barrier(0);
        }
#undef RES_LOAD
    }
};
struct SchedConv {
    int G, c;
    __device__ __forceinline__ bool next(int i, Unit& u) const {
        const long L = (long)i * G + c; if (L >= 65L * 22L) return false;
        tile_map((int)L, 65, 22, u.pm, u.pn); u.sub = 0;
        u.aoff = (size_t)((long)(254 * u.pm - 2) * 2048L); u.boff = (size_t)u.pn * (256 * 1024 * 2); return true;
    }
};
__device__ __forceinline__ float dpp_f(float oldv, float src, const int ctrl_sel) {
    const int o = __float_as_int(oldv), v = __float_as_int(src);
    return __int_as_float(ctrl_sel == 1 ? __builtin_amdgcn_update_dpp(o, v, 0x111, 0xf, 0xf, false) : __builtin_amdgcn_update_dpp(o, v, 0x112, 0xf, 0xf, false));
}
__device__ __forceinline__ float ror_f(float src, const int n) {
    const int v = __float_as_int(src);
    return __int_as_float(n == 1 ? __builtin_amdgcn_mov_dpp(v, 0x121, 0xf, 0xf, false) : __builtin_amdgcn_mov_dpp(v, 0x122, 0xf, 0xf, false));
}
struct EpiConv {
    static constexpr bool PERM = true, AFTER_DRAIN = false;
    bf16_t* ACT; const float* slots; const float* cw; PG8_LAS float* H;
    __device__ __forceinline__ bool zero_after(const Unit&) const { return true; }
    __device__ __forceinline__ void operator()(f32x4 (&acc)[2][2][4][2], const Unit& u, int wr, int wc, int fr_, int fq_) const {
        int fr = fr_, fq = fq_; asm volatile("" : "+v"(fr), "+v"(fq));
        const int arow0 = 254 * u.pm - 2, cl = wc * 32 + 8 * fq;
        PG8_LAS float* R = H + 3 * 2 * 256;
        PG8_LAS float* CWl = R + 256;
        { const int tl = (wr * 4 + wc) * 64 + fq * 16 + fr;
          if (tl < 256) { int row = arow0 + tl; row = row < 0 ? 0 : (row > 16383 ? 16383 : row); R[tl] = row_rstd(slots, row); }
          else if (tl < 448) { const int k = (tl - 256) >> 6, col = ((tl - 256) & 63) * 4; *(PG8_LAS f32x4*)(CWl + k * 256 + col) = *(const f32x4*)(cw + k * 5632 + (col < 128 ? 128 * u.pn + col : 2816 + 128 * u.pn + col - 128)); } }
#pragma unroll
        for (int ai = 0; ai < 2; ++ai) { const int s = 2 * ai + wr;
            if (s < 3 && fr >= 14) {
#pragma unroll
                for (int bj = 0; bj < 2; ++bj)
#pragma unroll
                    for (int n = 0; n < 2; ++n) *(PG8_LAS f32x4*)(H + (s * 2 + (fr - 14)) * 256 + bj * HALF + cl + 4 * n) = acc[ai][bj][3][n]; } }
        asm volatile("s_waitcnt vmcnt(0) lgkmcnt(0)" ::: "memory"); __builtin_amdgcn_s_barrier(); asm volatile("" ::: "memory");
#pragma unroll
        for (int ai = 0; ai < 2; ++ai)
#pragma unroll
            for (int m = 0; m < 4; ++m) { const float rs = R[ai * HALF + wr * 64 + m * 16 + fr];
#pragma unroll
                for (int bj = 0; bj < 2; ++bj) { acc[ai][bj][m][0] = acc[ai][bj][m][0] * rs; acc[ai][bj][m][1] = acc[ai][bj][m][1] * rs; } }
        const int tbg = (arow0 + wr * 64) & 8191; const bool gedge = (tbg >= 8177) || (tbg <= 1);
#pragma unroll
        for (int n = 0; n < 2; ++n) {
            f32x4 wg[3], wv[3];
#pragma unroll
            for (int k = 0; k < 3; ++k) { wg[k] = *(const PG8_LAS f32x4*)(CWl + k * 256 + cl + 4 * n); wv[k] = *(const PG8_LAS f32x4*)(CWl + k * 256 + 128 + cl + 4 * n); }
#pragma unroll
            for (int ai = 0; ai < 2; ++ai) {
                const int s = 2 * ai + wr;
                f32x4 h1[2], h2[2];
#pragma unroll
                for (int bj = 0; bj < 2; ++bj) {
                    if (s > 0) { h1[bj] = *(const PG8_LAS f32x4*)(H + ((s - 1) * 2 + 1) * 256 + bj * HALF + cl + 4 * n) * R[64 * s - 1]; h2[bj] = *(const PG8_LAS f32x4*)(H + ((s - 1) * 2 + 0) * 256 + bj * HALF + cl + 4 * n) * R[64 * s - 2]; }
                    else { h1[bj] = (f32x4){0.f, 0.f, 0.f, 0.f}; h2[bj] = (f32x4){0.f, 0.f, 0.f, 0.f}; } }
#pragma unroll
                for (int m = 0; m < 4; ++m) {
                    const int lr = ai * HALF + wr * 64 + m * 16 + fr, t = arow0 + lr, tb = t & 8191;
                    const bool k1 = tb >= 1, k2 = tb >= 2;
                    float o[4];
#pragma unroll
                    for (int jj = 0; jj < 4; ++jj) {
                        float cv[2];
#pragma unroll
                        for (int bj = 0; bj < 2; ++bj) {
                            const float cur = acc[ai][bj][m][n][jj];
                            float o1, o2;
                            if (m > 0) { const float prv = acc[ai][bj][m - 1][n][jj]; o1 = ror_f(prv, 1); o2 = ror_f(prv, 2); }
                            else { o1 = h1[bj][jj]; o2 = (fr == 0) ? h2[bj][jj] : o1; }
                            float x1 = dpp_f(o1, cur, 1), x2 = dpp_f(o2, cur, 2);
                            if (ai == 0 && m == 0) { x1 = (gedge && !k1) ? 0.f : x1; x2 = (gedge && !k2) ? 0.f : x2; }
                            cv[bj] = bj == 0 ? (wg[0][jj] * x2 + wg[1][jj] * x1 + wg[2][jj] * cur) : (wv[0][jj] * x2 + wv[1][jj] * x1 + wv[2][jj] * cur);
                        }
                        o[jj] = cv[0] * __builtin_amdgcn_rcpf(1.0f + __expf(-cv[0])) * cv[1];
                    }
                    u32x2 pk; pk.x = cvt_pk_bf16(o[0], o[1]); pk.y = cvt_pk_bf16(o[2], o[3]);
                    if (lr >= 2 && t < 16384) *(u32x2*)(ACT + (size_t)t * 2816 + 128 * u.pn + cl + 4 * n) = pk;
                    asm volatile("" ::: "memory");
                }
            }
        }
    }
};
}

#define LAS __attribute__((address_space(3)))
typedef pg8::bf16_t bf16;
typedef pg8::f32x4 f32x4;
typedef pg8::u32x4 u32x4;
typedef pg8::u32x2 u32x2;
typedef pg8::bf16x8 bf16x8;
constexpr int DM = 1024, SEQ = 8192, M = 16384, DEPTH = 2, INC = 6144, DFF = 2816, UPC = 5632;
constexpr size_t MiB = 1u << 20;
constexpr size_t WS_BAR = 16384;
constexpr size_t WS_SLOTS = 1 * MiB;
constexpr size_t WS_WIN = 2 * MiB, WS_WBR = 14 * MiB, WS_WO = 17 * MiB, WS_WUP = 19 * MiB, WS_WDN = 30 * MiB;
constexpr size_t WS_XB = 36 * MiB;
constexpr size_t WS_PA = 68 * MiB;
constexpr size_t WS_Y = 164 * MiB;
constexpr size_t WS_MG = 212 * MiB;
constexpr size_t WS_AP = 68 * MiB;
constexpr size_t WS_ACT = 156 * MiB;
constexpr size_t WS_WUP1 = 244 * MiB, WS_WDN1 = 19 * MiB;
constexpr size_t WS_END = 255 * MiB;
constexpr int LDS_BYTES = 143360, LDS_ST = 143360 - 64;

struct Args { const float* in[18]; float* out; unsigned char* ws; };
enum { I_X = 0, I_NMIX, I_WIN, I_SLN, I_SW, I_SB, I_CBW, I_PW, I_PS, I_WA, I_WB, I_WC, I_WO, I_NFFN, I_WUP, I_FCW, I_WDN, I_NF };

__device__ __forceinline__ int tid_l() { int t = threadIdx.x; asm volatile("" : "+v"(t)); return t; }
__device__ __forceinline__ float wave_sum(float v) {
#pragma unroll
    for (int o = 1; o < 64; o <<= 1) v += __shfl_xor(v, o);
    return v;
}
__device__ __forceinline__ unsigned pk2(float lo, float hi) { return pg8::cvt_pk_bf16(lo, hi); }
__device__ __forceinline__ float bf_lo(unsigned w) { return __uint_as_float(w << 16); }
__device__ __forceinline__ float bf_hi(unsigned w) { return __uint_as_float(w & 0xffff0000u); }

struct TrItem { const float* W; bf16* WT; const float* ksc; int K, N, dst_row0, k0, n0; };
__device__ __forceinline__ void tr_load(const TrItem& t, f32x4 (&v)[16], int lane) {
    const int r = lane >> 4, c4 = (lane & 15) * 4;
#pragma unroll
    for (int i = 0; i < 16; ++i) v[i] = *(const f32x4*)(t.W + (size_t)(t.k0 + 4 * i + r) * t.N + t.n0 + c4);
}
__device__ __forceinline__ void tr_store(const TrItem& t, const f32x4 (&v)[16], LAS float* scr, int lane) {
    const int r = lane >> 4, c4 = (lane & 15) * 4;
#pragma unroll
    for (int i = 0; i < 16; ++i) { const float sc = t.ksc ? t.ksc[t.k0 + 4 * i + r] : 1.0f; LAS float* d = scr + (4 * i + r) * 65 + c4; d[0] = v[i][0] * sc; d[1] = v[i][1] * sc; d[2] = v[i][2] * sc; d[3] = v[i][3] * sc; }
    asm volatile("s_waitcnt lgkmcnt(0)" ::: "memory");
    const int c = lane & 7;
#pragma unroll
    for (int j = 0; j < 8; ++j) { const int n = (lane >> 3) + 8 * j; const LAS float* s = scr + (8 * c) * 65 + n;
        u32x4 o; o.x = pk2(s[0 * 65], s[1 * 65]); o.y = pk2(s[2 * 65], s[3 * 65]); o.z = pk2(s[4 * 65], s[5 * 65]); o.w = pk2(s[6 * 65], s[7 * 65]);
        *(u32x4*)(t.WT + (size_t)(t.dst_row0 + n) * t.K + t.k0 + 8 * c) = o; }
    asm volatile("s_waitcnt lgkmcnt(0)" ::: "memory");
}
constexpr int CI_IN = (DM / 64) * (INC / 64), CI_BR = (512 / 64) * (DM / 64), CI_O = (DM / 64) * (DM / 64), CI_UP = (DM / 64) * (UPC / 64), CI_DN = (DFF / 64) * (DM / 64);
constexpr int CI_A = CI_IN + 3 * CI_BR + CI_O, CI_B = CI_A + CI_UP, CI_ALL = CI_B + CI_DN;
__device__ __forceinline__ TrItem tr_decode(const Args& a, int l, int it) {
    unsigned char* ws = a.ws; TrItem t; int r = it;
    if (r < CI_IN) { const int nblk = INC / 64, kb = r / nblk, nb = r % nblk; t.W = a.in[I_WIN] + (size_t)l * DM * INC; t.K = DM; t.N = INC; t.WT = (bf16*)(ws + WS_WIN); t.dst_row0 = 64 * nb; t.ksc = a.in[I_NMIX] + l * DM; t.k0 = 64 * kb; t.n0 = 64 * nb; return t; } r -= CI_IN;
    if (r < 3 * CI_BR) { const int br = r / CI_BR; r -= br * CI_BR; const int nblk = DM / 64, kb = r / nblk, nb = r % nblk;
        t.W = a.in[I_WA + br] + (size_t)l * 512 * DM; t.K = 512; t.N = DM; t.WT = (bf16*)(ws + WS_WBR); t.dst_row0 = br * 1024 + 64 * nb; t.ksc = nullptr; t.k0 = 64 * kb; t.n0 = 64 * nb; return t; } r -= 3 * CI_BR;
    if (r < CI_O) { const int nblk = DM / 64, kb = r / nblk, nb = r % nblk; t.W = a.in[I_WO] + (size_t)l * DM * DM; t.K = DM; t.N = DM; t.WT = (bf16*)(ws + WS_WO); t.dst_row0 = 64 * nb; t.ksc = nullptr; t.k0 = 64 * kb; t.n0 = 64 * nb; return t; } r -= CI_O;
    if (r < CI_UP) { const int nblk = UPC / 64, kb = r / nblk, nb = r % nblk; const int n0 = 64 * nb; const int j = n0 < DFF ? n0 : n0 - DFF;
        t.W = a.in[I_WUP] + (size_t)l * DM * UPC; t.K = DM; t.N = UPC; t.WT = (bf16*)(ws + (l == 0 ? WS_WUP : WS_WUP1)); t.dst_row0 = 256 * (j / 128) + (j % 128) + (n0 < DFF ? 0 : 128); t.ksc = a.in[I_NFFN] + l * DM; t.k0 = 64 * kb; t.n0 = n0; return t; } r -= CI_UP;
    { const int nblk = DM / 64, kb = r / nblk, nb = r % nblk; t.W = a.in[I_WDN] + (size_t)l * DFF * DM; t.K = DFF; t.N = DM; t.WT = (bf16*)(ws + (l == 0 ? WS_WDN : WS_WDN1)); t.dst_row0 = 64 * nb; t.ksc = nullptr; t.k0 = 64 * kb; t.n0 = 64 * nb; return t; }
}
__device__ __forceinline__ void convert_items(LAS unsigned char* lds, const Args& a, int l, int it_lo, int it_hi, int wk, int nwk) {
    const int tidl = tid_l(), lane = tidl & 63, wave = tidl >> 6;
    LAS float* scr = (LAS float*)(lds + wave * 16640);
    int it = it_lo + wk; if (it >= it_hi) return;
    TrItem cur = tr_decode(a, l, it); f32x4 v[16]; tr_load(cur, v, lane);
    for (;;) {
        const int itn = it + nwk; const bool more = itn < it_hi;
        f32x4 w[16]; TrItem nxt = cur;
        if (more) { nxt = tr_decode(a, l, itn); tr_load(nxt, w, lane); }
        tr_store(cur, v, scr, lane);
        if (!more) break;
#pragma unroll
        for (int i = 0; i < 16; ++i) v[i] = w[i];
        cur = nxt; it = itn;
    }
}
__device__ __forceinline__ void xprep_phase(const Args& a) {
    const int tidl = tid_l(), lane = tidl & 63, wave = tidl >> 6;
    const int gw = blockIdx.x * 8 + wave, NGW = gridDim.x * 8;
    unsigned char* ws = a.ws;
    {
        const float* x = a.in[I_X]; bf16* xb = (bf16*)(ws + WS_XB); float* slots = (float*)(ws + WS_SLOTS);
        for (int m = gw; m < M; m += NGW) {
            const f32x4* xr = (const f32x4*)(x + (size_t)m * DM) + lane; f32x4 v[4]; float s = 0.f;
#pragma unroll
            for (int j = 0; j < 4; ++j) { v[j] = xr[64 * j]; s += (v[j][0] * v[j][0] + v[j][1] * v[j][1]) + (v[j][2] * v[j][2] + v[j][3] * v[j][3]); }
            s = wave_sum(s);
            u32x2* o8 = (u32x2*)(xb + (size_t)m * DM) + lane;
#pragma unroll
            for (int j = 0; j < 4; ++j) { u32x2 w; w.x = pk2(v[j][0], v[j][1]); w.y = pk2(v[j][2], v[j][3]); o8[64 * j] = w; }
            if (lane < 4) { f32x4 z = (f32x4){0.f, 0.f, 0.f, 0.f}; if (lane == 0) z[0] = s; ((f32x4*)(slots + (size_t)m * 16))[lane] = z; }
        }
    }
}

#define LDS_BAR() asm volatile("s_waitcnt lgkmcnt(0)\n\ts_barrier" ::: "memory")
__device__ __forceinline__ void mixer_phase(LAS unsigned char* lds, const Args& a, int l) {
    const int tid = tid_l(), lane = tid & 63, wid = tid >> 6, r16 = lane & 15, q = lane >> 4;
    LAS bf16* Wl = (LAS bf16*)lds;
    LAS bf16* Tl = (LAS bf16*)(lds + 34816);
    LAS float* Fl = (LAS float*)(lds + 69632);
    LAS bf16* Zl = (LAS bf16*)(lds + 70656);
    const bf16* PA = (const bf16*)(a.ws + WS_PA); bf16* Y = (bf16*)(a.ws + WS_Y);
    int cur_job = -1; bool have = false;
    u32x4 pf[5];
#pragma unroll
    for (int k = 0; k < 5; ++k) pf[k] = (u32x4){0u, 0u, 0u, 0u};
    const bool split = (gridDim.x == 256); const int cb = blockIdx.x;
    int sj = 0, srank = 0, sn = 1;
    if (split) { if (cb < 104) { sj = cb / 13; srank = cb % 13; sn = 13; } else if (cb < 168) { sj = 8 + (cb - 104) / 16; srank = (cb - 104) % 16; sn = 16; } else { sj = 12 + (cb - 168) / 22; srank = (cb - 168) % 22; sn = 22; } }
    for (int it = 0;; ++it) {
        int job, blk, jobn, blkn; bool okn;
        if (split) { blk = srank + it * sn; if (blk >= 128) break; job = sj; blkn = blk + sn; okn = blkn < 128; jobn = sj; }
        else { const int u = cb + it * (int)gridDim.x; if (u >= 2048) break; job = u & 15; blk = u >> 4; const int un = u + (int)gridDim.x; okn = un < 2048; jobn = un & 15; blkn = un >> 4; }
        const int R0 = blk * 128; const bool pre = okn && (jobn == job); const int R0n = blkn * 128;
        if (job != cur_job) {
            __syncthreads();
            if (job < 8) {
                const float* W = a.in[I_SW] + (size_t)(l * 8 + job) * 16384;
                for (int idx = tid; idx < 4096; idx += 512) { const int i = idx >> 5, j0 = (idx & 31) * 4; f32x4 w = *(const f32x4*)(W + i * 128 + j0);
                    if (i < 64 && j0 >= 64) w = (f32x4){0.f, 0.f, 0.f, 0.f};
                    u32x2 o; o.x = pk2(w[0], w[1]); o.y = pk2(w[2], w[3]); *(LAS u32x2*)(Wl + i * 136 + j0) = o; }
                if (tid < 128) Fl[tid] = a.in[I_SB][(l * 8 + job) * 128 + tid];
                else if (tid < 192) Fl[tid] = a.in[I_SLN][l * 512 + job * 64 + (tid - 128)];
            } else if (job >= 12) {
                const int g = job - 12; const float* W = a.in[I_PW] + (size_t)(l * 4 + g) * 16384;
                for (int idx = tid; idx < 4096; idx += 512) { const int c = idx & 127, d0 = (idx >> 7) * 4; const f32x4 w = *(const f32x4*)(W + c * 128 + d0);
#pragma unroll
                    for (int e = 0; e < 4; ++e) Wl[(d0 + e) * 136 + c] = (bf16)(pk2(w[e], 0.f) & 0xffffu); }
                if (tid < 128) Fl[tid] = a.in[I_PS][l * 512 + g * 128 + tid];
            }
            __syncthreads();
            cur_job = job; have = false;
        }
        if (job < 8) {
            const int g = job, vrow = tid >> 2, ch0 = (tid & 3) * 16, ui = 16 * wid + r16;
#define SGU_LOAD(R) do { const u32x4* src_ = (const u32x4*)(PA + (size_t)((R) + vrow) * 3072 + 512 + g * 64 + ch0); pf[0] = src_[0]; pf[1] = src_[1]; \
                const bf16* up_ = PA + (size_t)((R) + 16 * wid + (lane >> 3)) * 3072 + g * 64 + 8 * (lane & 7); pf[2] = *(const u32x4*)(up_); pf[3] = *(const u32x4*)(up_ + 8 * 3072); } while (0)
            if (!have) SGU_LOAD(R0);
            const u32x4 cv0 = pf[0], cv1 = pf[1], cu0 = pf[2], cu1 = pf[3];
            if (pre) SGU_LOAD(R0n);
            have = pre;
#undef SGU_LOAD
            {
                float v[16]; { float t0[8], t1[8]; pg8::unpack8(cv0, t0); pg8::unpack8(cv1, t1);
#pragma unroll
                    for (int e = 0; e < 8; ++e) { v[e] = t0[e]; v[8 + e] = t1[e]; } }
                float s = 0.f;
#pragma unroll
                for (int e = 0; e < 16; ++e) s += v[e];
                s += __shfl_xor(s, 1); s += __shfl_xor(s, 2);
                const float mu = s * (1.0f / 64.0f); float s2 = 0.f;
#pragma unroll
                for (int e = 0; e < 16; ++e) { v[e] -= mu; s2 += v[e] * v[e]; }
                s2 += __shfl_xor(s2, 1); s2 += __shfl_xor(s2, 2);
                const float rstd = rsqrtf(s2 * (1.0f / 64.0f) + 1e-6f);
#pragma unroll
                for (int e = 0; e < 16; ++e) Tl[(ch0 + e) * 136 + vrow] = (bf16)(pk2(v[e] * rstd * Fl[128 + ch0 + e], 0.f) & 0xffffu);
            }
            LDS_BAR();
            f32x4 acc[4];
#pragma unroll
            for (int ct = 0; ct < 4; ++ct) acc[ct] = (f32x4){0.f, 0.f, 0.f, 0.f};
#pragma unroll
            for (int ks = 0; ks < 4; ++ks) {
                const bf16x8 bfr = *(const LAS bf16x8*)(Wl + (16 * wid + r16) * 136 + 32 * ks + 8 * q);
#pragma unroll
                for (int ct = 0; ct < 4; ++ct) { const bf16x8 afr = *(const LAS bf16x8*)(Tl + (16 * ct + r16) * 136 + 32 * ks + 8 * q);
                    acc[ct] = __builtin_amdgcn_mfma_f32_16x16x32_bf16(afr, bfr, acc[ct], 0, 0, 0); }
            }
            {
                LAS float* Sl = (LAS float*)Zl;
                const float bias = Fl[ui];
#pragma unroll
                for (int ct = 0; ct < 4; ++ct) *(LAS f32x4*)(Sl + ui * 68 + 16 * ct + 4 * q) = acc[ct] + bias;
                asm volatile("s_waitcnt lgkmcnt(0)" ::: "memory");
#pragma unroll
                for (int k = 0; k < 2; ++k) { const int i = 16 * wid + (lane >> 3) + 8 * k, c8 = 8 * (lane & 7);
                    const f32x4 s0 = *(const LAS f32x4*)(Sl + i * 68 + c8), s1 = *(const LAS f32x4*)(Sl + i * 68 + c8 + 4);
                    float uf[8]; pg8::unpack8(k == 0 ? cu0 : cu1, uf);
                    u32x4 o; o.x = pk2(uf[0] * s0[0], uf[1] * s0[1]); o.y = pk2(uf[2] * s0[2], uf[3] * s0[3]); o.z = pk2(uf[4] * s1[0], uf[5] * s1[1]); o.w = pk2(uf[6] * s1[2], uf[7] * s1[3]);
                    *(u32x4*)(Y + (size_t)(R0 + i) * 1536 + g * 64 + c8) = o; }
            }
            LDS_BAR();
        } else if (job < 12) {
            const int c0 = 128 * (job - 8) + 8 * (tid & 15), gr0 = R0 + 4 * (tid >> 4), tb0 = gr0 & (SEQ - 1);
            const float* cw = a.in[I_CBW] + (size_t)l * 3 * 512 + c0;
            float w0[8], w1[8], w2[8];
            { const f32x4 a0 = *(const f32x4*)(cw), a1 = *(const f32x4*)(cw + 4), b0 = *(const f32x4*)(cw + 512), b1 = *(const f32x4*)(cw + 516), d0 = *(const f32x4*)(cw + 1024), d1 = *(const f32x4*)(cw + 1028);
#pragma unroll
              for (int e = 0; e < 4; ++e) { w0[e] = a0[e]; w0[4 + e] = a1[e]; w1[e] = b0[e]; w1[4 + e] = b1[e]; w2[e] = d0[e]; w2[4 + e] = d1[e]; } }
            float z2[8], z1[8];
#pragma unroll
            for (int e = 0; e < 8; ++e) { z2[e] = 0.f; z1[e] = 0.f; }
            if (tb0 >= 2) { float cgv[8], xv[8]; const bf16* p = PA + (size_t)(gr0 - 2) * 3072 + c0; pg8::unpack8(*(const u32x4*)(p + 1536), cgv); pg8::unpack8(*(const u32x4*)(p + 2048), xv);
#pragma unroll
                for (int e = 0; e < 8; ++e) z2[e] = cgv[e] * xv[e]; }
            if (tb0 >= 1) { float cgv[8], xv[8]; const bf16* p = PA + (size_t)(gr0 - 1) * 3072 + c0; pg8::unpack8(*(const u32x4*)(p + 1536), cgv); pg8::unpack8(*(const u32x4*)(p + 2048), xv);
#pragma unroll
                for (int e = 0; e < 8; ++e) z1[e] = cgv[e] * xv[e]; }
#pragma unroll
            for (int rr = 0; rr < 4; ++rr) {
                const bf16* p = PA + (size_t)(gr0 + rr) * 3072 + c0; float bgv[8], cgv[8], xv[8], o[8];
                pg8::unpack8(*(const u32x4*)(p + 1024), bgv); pg8::unpack8(*(const u32x4*)(p + 1536), cgv); pg8::unpack8(*(const u32x4*)(p + 2048), xv);
#pragma unroll
                for (int e = 0; e < 8; ++e) { const float z0 = cgv[e] * xv[e]; o[e] = bgv[e] * (w0[e] * z2[e] + w1[e] * z1[e] + w2[e] * z0); z2[e] = z1[e]; z1[e] = z0; }
                u32x4 w; w.x = pk2(o[0], o[1]); w.y = pk2(o[2], o[3]); w.z = pk2(o[4], o[5]); w.w = pk2(o[6], o[7]);
                *(u32x4*)(Y + (size_t)(gr0 + rr) * 1536 + 512 + c0) = w;
            }
        } else {
            const int g = job - 12, win = 2 << g, c0 = 8 * (tid & 15), rl0 = 4 * (tid >> 4), tb0 = (R0 + rl0) & (SEQ - 1);
            const bf16* zc = PA + 2560 + 128 * g;
#define POOL_LOAD(R) do { const int tbb_ = ((R) & (SEQ - 1)) - 15; _Pragma("unroll") for (int k = 0; k < 5; ++k) { const int idx_ = tid + 512 * k, row_ = idx_ >> 4, ch_ = idx_ & 15; \
                pf[k] = (idx_ < 2288 && tbb_ + row_ >= 0) ? *(const u32x4*)(zc + (size_t)((R) - 15 + row_) * 3072 + 8 * ch_) : (u32x4){0u, 0u, 0u, 0u}; } } while (0)
            if (!have) POOL_LOAD(R0);
#pragma unroll
            for (int k = 0; k < 5; ++k) { const int idx = tid + 512 * k, row = idx >> 4, ch = idx & 15; if (idx < 2288) *(LAS u32x4*)(Zl + row * 136 + 8 * ch) = pf[k]; }
            if (pre) POOL_LOAD(R0n);
            have = pre;
#undef POOL_LOAD
            LDS_BAR();
            float S[8];
#pragma unroll
            for (int e = 0; e < 8; ++e) S[e] = 0.f;
#pragma unroll
            for (int d = 15; d >= 1; --d) { if (d < win) { float z[8]; pg8::unpack8(*(const LAS u32x4*)(Zl + (15 + rl0 - d) * 136 + c0), z);
#pragma unroll
                for (int e = 0; e < 8; ++e) S[e] += z[e]; } }
#pragma unroll
            for (int rr = 0; rr < 4; ++rr) {
                float z[8]; pg8::unpack8(*(const LAS u32x4*)(Zl + (15 + rl0 + rr) * 136 + c0), z);
#pragma unroll
                for (int e = 0; e < 8; ++e) S[e] += z[e];
                if (rr > 0) { float zo[8]; pg8::unpack8(*(const LAS u32x4*)(Zl + (15 + rl0 + rr - win) * 136 + c0), zo);
#pragma unroll
                    for (int e = 0; e < 8; ++e) S[e] -= zo[e]; }
                const int tb = tb0 + rr; const float inv = 1.0f / (float)((tb + 1) < win ? (tb + 1) : win); float o[8];
#pragma unroll
                for (int e = 0; e < 8; ++e) o[e] = S[e] * inv - z[e];
                u32x4 w; w.x = pk2(o[0], o[1]); w.y = pk2(o[2], o[3]); w.z = pk2(o[4], o[5]); w.w = pk2(o[6], o[7]);
                *(LAS u32x4*)(Tl + (rl0 + rr) * 136 + c0) = w;
            }
            LDS_BAR();
            f32x4 acc[8];
#pragma unroll
            for (int dt = 0; dt < 8; ++dt) acc[dt] = (f32x4){0.f, 0.f, 0.f, 0.f};
#pragma unroll
            for (int ks = 0; ks < 4; ++ks) {
                const bf16x8 bfr = *(const LAS bf16x8*)(Tl + (16 * wid + r16) * 136 + 32 * ks + 8 * q);
#pragma unroll
                for (int dt = 0; dt < 8; ++dt) { const bf16x8 afr = *(const LAS bf16x8*)(Wl + (16 * dt + r16) * 136 + 32 * ks + 8 * q);
                    acc[dt] = __builtin_amdgcn_mfma_f32_16x16x32_bf16(afr, bfr, acc[dt], 0, 0, 0); }
            }
            {
                const int t = 16 * wid + r16;
#pragma unroll
                for (int dt = 0; dt < 8; ++dt) { const int d0 = 16 * dt + 4 * q; const f32x4 sc = *(const LAS f32x4*)(Fl + d0);
                    u32x2 o; o.x = pk2(acc[dt][0] * sc[0], acc[dt][1] * sc[1]); o.y = pk2(acc[dt][2] * sc[2], acc[dt][3] * sc[3]);
                    *(LAS u32x2*)(Tl + t * 136 + d0) = o; }
                asm volatile("s_waitcnt lgkmcnt(0)" ::: "memory");
#pragma unroll
                for (int k = 0; k < 4; ++k) { const int row = 16 * wid + (lane >> 4) + 4 * k, ch = lane & 15;
                    *(u32x4*)(Y + (size_t)(R0 + row) * 1536 + 1024 + 128 * g + 8 * ch) = *(const LAS u32x4*)(Tl + row * 136 + 8 * ch); }
            }
            LDS_BAR();
        }
    }
}

__device__ __forceinline__ void ffn_conv_phase(const Args& a, int l, int half) {
    const bf16* AP = (const bf16*)(a.ws + WS_AP); bf16* ACT = (bf16*)(a.ws + WS_ACT);
    const int gtid = blockIdx.x * 512 + tid_l(), nth = gridDim.x * 512;
    for (int it = gtid; it < 1024 * 11 * 16; it += nth) {
        const int chg = it & 15, tmp = it >> 4, n = tmp % 11, rc = tmp / 11;
        const int jg = 128 * (n + 11 * half) + 8 * chg, cb = 256 * n + 8 * chg, gr0 = 16 * rc, tb0 = gr0 & (SEQ - 1);
        const float* cw = a.in[I_FCW] + (size_t)l * 3 * UPC + jg;
        float wg[3][8], wv[3][8];
#pragma unroll
        for (int k = 0; k < 3; ++k) { const f32x4 g0 = *(const f32x4*)(cw + k * UPC), g1 = *(const f32x4*)(cw + k * UPC + 4), v0 = *(const f32x4*)(cw + k * UPC + DFF), v1 = *(const f32x4*)(cw + k * UPC + DFF + 4);
#pragma unroll
            for (int e = 0; e < 4; ++e) { wg[k][e] = g0[e]; wg[k][4 + e] = g1[e]; wv[k][e] = v0[e]; wv[k][4 + e] = v1[e]; } }
        float g2[8], g1[8], v2[8], v1[8];
#pragma unroll
        for (int e = 0; e < 8; ++e) { g2[e] = 0.f; g1[e] = 0.f; v2[e] = 0.f; v1[e] = 0.f; }
        if (tb0 >= 2) { const bf16* p = AP + (size_t)(gr0 - 2) * DFF + cb; pg8::unpack8(*(const u32x4*)p, g2); pg8::unpack8(*(const u32x4*)(p + 128), v2); }
        if (tb0 >= 1) { const bf16* p = AP + (size_t)(gr0 - 1) * DFF + cb; pg8::unpack8(*(const u32x4*)p, g1); pg8::unpack8(*(const u32x4*)(p + 128), v1); }
#pragma unroll 4
        for (int rr = 0; rr < 16; ++rr) {
            const bf16* p = AP + (size_t)(gr0 + rr) * DFF + cb; float g0[8], v0[8], o[8];
            pg8::unpack8(*(const u32x4*)p, g0); pg8::unpack8(*(const u32x4*)(p + 128), v0);
#pragma unroll
            for (int e = 0; e < 8; ++e) {
                const float ag = wg[0][e] * g2[e] + wg[1][e] * g1[e] + wg[2][e] * g0[e], av = wv[0][e] * v2[e] + wv[1][e] * v1[e] + wv[2][e] * v0[e];
                o[e] = ag * __builtin_amdgcn_rcpf(1.0f + __expf(-ag)) * av;
                g2[e] = g1[e]; g1[e] = g0[e]; v2[e] = v1[e]; v1[e] = v0[e]; }
            u32x4 w; w.x = pk2(o[0], o[1]); w.y = pk2(o[2], o[3]); w.z = pk2(o[4], o[5]); w.w = pk2(o[6], o[7]);
            *(u32x4*)(ACT + (size_t)(gr0 + rr) * DFF + jg) = w;
        }
    }
}

__device__ __forceinline__ void final_norm(const Args& a) {
    const int tidl = tid_l(), lane = tidl & 63, gw = blockIdx.x * 8 + (tidl >> 6), NGW = gridDim.x * 8;
    const f32x4* gp = (const f32x4*)a.in[I_NF] + lane; const bf16* XB = (const bf16*)(a.ws + WS_XB); const float* slots = (const float*)(a.ws + WS_SLOTS);
    f32x4 gv[4];
#pragma unroll
    for (int j = 0; j < 4; ++j) gv[j] = gp[64 * j];
    for (int m = gw; m < M; m += NGW) {
        const u32x2* xr = (const u32x2*)(XB + (size_t)m * DM) + lane; u32x2 v[4];
#pragma unroll
        for (int j = 0; j < 4; ++j) v[j] = xr[64 * j];
        const float rs = pg8::row_rstd(slots, m);
        f32x4* orow = (f32x4*)(a.out + (size_t)m * DM) + lane;
#pragma unroll
        for (int j = 0; j < 4; ++j) orow[64 * j] = (f32x4){bf_lo(v[j].x), bf_hi(v[j].x), bf_lo(v[j].y), bf_hi(v[j].y)} * rs * gv[j];
    }
}

#define XB_TMO      128
#define XB_XCNT(j)  (256  + 64 * (j))
#define XB_XSUB(j)  (1280 + 64 * (j))
#define XB_XGEN(j)  (2304 + 64 * (j))
#define XB_TOP      3328
#define XB_TOPGEN   3392
#define XCD_BAR_WORDS 3456
#define XB_SPIN_CAP (1u << 18)

__device__ __forceinline__ unsigned xb_ld(unsigned* p)              { return __hip_atomic_load(p, __ATOMIC_RELAXED, __HIP_MEMORY_SCOPE_AGENT); }
__device__ __forceinline__ unsigned xb_add(unsigned* p, unsigned v) { return __hip_atomic_fetch_add(p, v, __ATOMIC_RELAXED, __HIP_MEMORY_SCOPE_AGENT); }
__device__ __forceinline__ unsigned xb_xcc_id() { return (unsigned)__builtin_amdgcn_s_getreg((3 << 11) | 20) & 0xFu; }
#define XB_SPIN(cond, bar) do { unsigned _sp = 0; while (cond) { __builtin_amdgcn_s_sleep(1); \
    if ((++_sp & 255u) == 0u) { if (xb_ld(&(bar)[XB_TMO])) break; if (_sp > XB_SPIN_CAP) { atomicAdd(&(bar)[XB_TMO], 1u); break; } } } } while (0)

struct XcdBarrier {
    unsigned* bar; unsigned x;
    volatile LAS unsigned* st;
};

__device__ __forceinline__ XcdBarrier xcd_barrier_post(unsigned* bar, volatile LAS unsigned* st) {
    XcdBarrier b; b.bar = bar; b.x = xb_xcc_id(); b.st = st;
    if (threadIdx.x == 0) (void)xb_add(&bar[XB_XCNT(b.x)], 1u);
    return b;
}
__device__ __forceinline__ void xcd_barrier_complete(unsigned* bar, unsigned x, unsigned& nloc, unsigned& nx) {
    const unsigned G = gridDim.x * gridDim.y * gridDim.z;
    unsigned sum, cnt, mine, sp = 0u;
    for (;;) {
        sum = 0u; cnt = 0u; mine = 0u;
#pragma unroll
        for (unsigned j = 0; j < 16; ++j) { const unsigned c = xb_ld(&bar[XB_XCNT(j)]); sum += c; cnt += (c > 0u) ? 1u : 0u; mine = (j == x) ? c : mine; }
        if (sum == G) break;
        __builtin_amdgcn_s_sleep(1);
        if ((++sp & 255u) == 0u) { if (xb_ld(&bar[XB_TMO])) break; if (sp > XB_SPIN_CAP) { atomicAdd(&bar[XB_TMO], 1u); break; } }
    }
    nloc = mine > 0u ? mine : 1u; nx = cnt > 0u ? cnt : 1u;
}

__device__ __forceinline__ void xcd_barrier(const XcdBarrier& b) {
    asm volatile("s_waitcnt vmcnt(0)" ::: "memory");
    __syncthreads();
    if (threadIdx.x == 0) {
        unsigned* bar = b.bar;
        __builtin_amdgcn_s_waitcnt(0);
        unsigned nloc = b.st[0], nx = b.st[1];
        if (nloc == 0u) { xcd_barrier_complete(bar, b.x, nloc, nx); b.st[0] = nloc; b.st[1] = nx; }
        const unsigned old = xb_add(&bar[XB_XSUB(b.x)], 1u);
        const unsigned gen = old / nloc;
        if (old + 1u == (gen + 1u) * nloc) {
            __builtin_amdgcn_fence(__ATOMIC_RELEASE, "agent");
            asm volatile("s_waitcnt vmcnt(0)" ::: "memory");
            const unsigned og = xb_add(&bar[XB_TOP], 1u);
            const unsigned tg = og / nx;
            if (og + 1u == (tg + 1u) * nx) xb_add(&bar[XB_TOPGEN], 1u);
            else XB_SPIN(xb_ld(&bar[XB_TOPGEN]) == tg, bar);
            __builtin_amdgcn_fence(__ATOMIC_ACQUIRE, "agent");
            xb_add(&bar[XB_XGEN(b.x)], 1u);
            asm volatile("s_waitcnt vmcnt(0)" ::: "memory");
        } else {
            XB_SPIN(xb_ld(&bar[XB_XGEN(b.x)]) == gen, bar);
            __builtin_amdgcn_fence(__ATOMIC_ACQUIRE, "agent");
            asm volatile("s_waitcnt vmcnt(0)" ::: "memory");
        }
    }
    __syncthreads();
}

__global__ void __launch_bounds__(512, 2) fwd_kernel(Args a) {
    extern __shared__ __attribute__((aligned(16))) unsigned char lds_raw[];
    LAS unsigned char* lds = (LAS unsigned char*)lds_raw;
    cg::grid_group grid = cg::this_grid();
    const int G = gridDim.x, c = blockIdx.x;
    unsigned char* ws = a.ws;
    unsigned* barw = (unsigned*)(ws + WS_BAR);
    if (blockIdx.x == 0) for (int i = threadIdx.x; i < XCD_BAR_WORDS; i += 512) barw[i] = 0u;
    if (threadIdx.x < 2) ((volatile LAS unsigned*)(lds + LDS_ST))[threadIdx.x] = 0u;
    grid.sync();
    const XcdBarrier bar = xcd_barrier_post(barw, (volatile LAS unsigned*)(lds + LDS_ST));
    float* slots = (float*)(ws + WS_SLOTS);
    bf16* XB = (bf16*)(ws + WS_XB);
#pragma unroll 1
    for (int l = 0; l < DEPTH; ++l) {
#pragma unroll 1
        for (int ph = 0; ph < 11; ++ph) {
            if (ph == 0) { if (l != 0) continue;
                convert_items(lds, a, 0, 0, CI_ALL, c * 8 + (tid_l() >> 6), G * 8); xprep_phase(a); }
            else if (ph == 7 || ph == 8 || ph == 9) continue;
            else if (ph == 6) {
                pg8::Gemm g{XB, (const bf16*)(ws + (l == 0 ? WS_WUP : WS_WUP1)), DM, DM, DM};
                pg8::SchedConv S{G, c};
                pg8::EpiConv E{(bf16*)(ws + WS_ACT), slots, a.in[I_FCW] + (size_t)l * 3 * UPC, (LAS float*)(lds + 131072)};
                pg8::gemm_phase<pg8::EpiConv, pg8::SchedConv, true, true>(lds, g, S, E);
                if (l + 1 < DEPTH) {
                    const bool idle = (G == 256); const int wv = tid_l() >> 6;
                    if (!idle || c >= 150) convert_items(lds, a, l + 1, 0, CI_B, idle ? (c - 150) * 8 + wv : c * 8 + wv, idle ? 106 * 8 : G * 8);
                }
            }
            else if (ph == 1) {
                const bf16* Bt = (const bf16*)(ws + WS_WIN) + (size_t)0 * DM;
                pg8::Gemm g{XB, Bt, DM, DM, DM};
                pg8::SchedPlain S{M / 256, 3072 / 256, G, c, (size_t)256 * DM * 2, (size_t)256 * DM * 2};
                pg8::EpiAct E{(bf16*)(ws + WS_PA), 3072, slots, 0, (LAS float*)(lds + 131072)};
                pg8::gemm_phase<pg8::EpiAct, pg8::SchedPlain, true, true>(lds, g, S, E);
            }
            else if (ph == 3) {
                const bf16* Bt = (const bf16*)(ws + WS_WIN) + (size_t)3072 * DM;
                pg8::Gemm g{XB, Bt, DM, DM, DM};
                pg8::SchedPlain S{M / 256, 3072 / 256, G, c, (size_t)256 * DM * 2, (size_t)256 * DM * 2};
                pg8::EpiAct E{(bf16*)(ws + WS_PA), 3072, slots, 1, (LAS float*)(lds + 131072)};
                pg8::gemm_phase<pg8::EpiAct, pg8::SchedPlain, true, true>(lds, g, S, E);
            }
            else if (ph == 2) mixer_phase(lds, a, l);
            else if (ph == 4) {
                pg8::Gemm g{(const bf16*)(ws + WS_Y), (const bf16*)(ws + WS_WBR), 1536, 512, 512};
                pg8::SchedBranch S{M / 256, DM / 256, G, c};
                pg8::EpiGate E{(const bf16*)(ws + WS_PA), (bf16*)(ws + WS_MG)};
                pg8::gemm_phase<pg8::EpiGate, pg8::SchedBranch, true, true>(lds, g, S, E);
            }
            else if (ph == 5 || ph == 10) {
                const bool dn = ph == 10;
                pg8::Gemm g{dn ? (const bf16*)(ws + WS_ACT) : (const bf16*)(ws + WS_MG), dn ? (const bf16*)(ws + (l == 0 ? WS_WDN : WS_WDN1)) : (const bf16*)(ws + WS_WO), dn ? DFF : DM, dn ? DFF : DM, dn ? DFF : DM};
                pg8::SchedPlain S{M / 256, DM / 256, G, c, (size_t)256 * (dn ? DFF : DM) * 2, (size_t)256 * (dn ? DFF : DM) * 2};
                pg8::EpiRes E{XB, slots};
                pg8::gemm_phase<pg8::EpiRes, pg8::SchedPlain, true, true>(lds, g, S, E);
                if (dn && l + 1 < DEPTH) convert_items(lds, a, l + 1, CI_B, CI_ALL, c * 8 + (tid_l() >> 6), G * 8);
            }
            xcd_barrier(bar);
        }
    }
    final_norm(a);
}

extern "C" void kernel_launch(void* const* d_in, const int* in_sizes, int n_in, void* d_out, int out_size, void* d_ws, size_t ws_size, hipStream_t stream) {
    static int grid = 0;
    if (grid == 0) {
        if (n_in != 18 || out_size != M * DM || ws_size < WS_END) { fprintf(stderr, "kernel_launch: unexpected shapes (n_in %d, out %d, ws %zu)\n", n_in, out_size, ws_size); grid = -1; return; }
        int dev = 0, cus = 0, per_cu = 0;
        hipGetDevice(&dev); hipDeviceGetAttribute(&cus, hipDeviceAttributeMultiprocessorCount, dev);
        if (hipFuncSetAttribute((const void*)fwd_kernel, hipFuncAttributeMaxDynamicSharedMemorySize, LDS_BYTES) != hipSuccess) { fprintf(stderr, "kernel_launch: hipFuncSetAttribute failed\n"); grid = -1; return; }
        if (hipOccupancyMaxActiveBlocksPerMultiprocessor(&per_cu, (const void*)fwd_kernel, 512, LDS_BYTES) != hipSuccess || per_cu < 1) { fprintf(stderr, "kernel_launch: occupancy query failed (%d)\n", per_cu); grid = -1; return; }
        grid = cus;
    }
    if (grid < 0) return;
    Args a{};
    for (int i = 0; i < 18; ++i) a.in[i] = (const float*)d_in[i];
    a.out = (float*)d_out; a.ws = (unsigned char*)d_ws;
    void* args[] = {&a};
    hipError_t e = hipLaunchCooperativeKernel((const void*)fwd_kernel, dim3(grid), dim3(512), args, LDS_BYTES, stream);
    if (e != hipSuccess) fprintf(stderr, "kernel_launch: cooperative launch failed: %s (grid %d)\n", hipGetErrorString(e), grid);
}
```

```cpp
#include <hip/hip_runtime.h>
#include <hip/hip_cooperative_groups.h>
#include <cstdio>
#include <cstdint>
namespace cg = cooperative_groups;

namespace pg8 {
#define PG8_LAS __attribute__((address_space(3)))
typedef unsigned short bf16_t;
typedef short bf16x8 __attribute__((ext_vector_type(8)));
typedef float f32x4 __attribute__((ext_vector_type(4)));
typedef unsigned u32x4 __attribute__((ext_vector_type(4)));
typedef unsigned u32x2 __attribute__((ext_vector_type(2)));
constexpr int BM = 256, BK = 64, HALF = 128, HTB = HALF * BK * 2  , STAGE_BYTES = 8 * HTB, NXCD = 8, WGM = 8;

__host__ __device__ __forceinline__ int lds_byte(int r, int c) { const int st = (r >> 4) * 2 + (c >> 5), rr = r & 15, cc = c & 31, ob = rr * 64 + cc * 2; return st * 1024 + (ob ^ (((ob >> 9) & 1) << 5)); }
__host__ __device__ __forceinline__ void stage_rc(int b, int& R, int& C) { const int st = b / 1024, sb = b % 1024, swz = sb ^ (((sb >> 9) & 1) << 5); R = (st >> 1) * 16 + swz / 64; C = (st & 1) * 32 + (swz % 64) / 2; }
__host__ __device__ __forceinline__ int perm32(int rho) { const int n = rho >> 4, i = rho & 15; return 8 * (i >> 2) + 4 * n + (i & 3); }

struct Unit { int pm, pn, sub; size_t aoff, boff; };
struct Gemm { const bf16_t* A; const bf16_t* Bt; int lda, ldb, K; };

__device__ __forceinline__ unsigned cvt_pk_bf16(float lo, float hi) { unsigned r; asm volatile("s_nop 0\n\tv_cvt_pk_bf16_f32 %0, %1, %2" : "=v"(r) : "v"(lo), "v"(hi)); return r; }
typedef float f32x2 __attribute__((ext_vector_type(2)));
__device__ __forceinline__ f32x2 gelu_pk(f32x2 v) {
    const f32x2 av = __builtin_elementwise_abs(v), d = av * 0.2316418882f + 1.0f;
    f32x2 t; t.x = __builtin_amdgcn_rcpf(d.x); t.y = __builtin_amdgcn_rcpf(d.y);
    f32x2 q = t * 0.5307027145f + (-0.7265760135f); q = q * t + 0.7107068705f; q = q * t + (-0.142248368f); q = q * t + 0.127414796f; q = q * t;
    const f32x2 s = (v * v) * (-0.72134752044f);
    f32x2 e; e.x = __builtin_amdgcn_exp2f(s.x); e.y = __builtin_amdgcn_exp2f(s.y);
    const f32x2 m = v * (q * e), r = v - m;
    f32x2 o; o.x = v.x < 0.f ? m.x : r.x; o.y = v.y < 0.f ? m.y : r.y; return o;
}

template <class Epi, class Sched, bool ALIGN_EPI = false, bool SP2 = false>
__device__ __forceinline__ void gemm_phase(PG8_LAS unsigned char* lds, const Gemm g, const Sched& S, const Epi& E) {
    int tid_ = threadIdx.x; asm volatile("" : "+v"(tid_));
    const int tid = tid_, wid = __builtin_amdgcn_readfirstlane(tid >> 6), lane = tid & 63, wr = wid >> 2, wc = wid & 3, fr = lane & 15, fq = lane >> 4;
    const int K = g.K, nt = K / BK;
    unsigned voffA[2], voffB[2];
#pragma unroll
    for (int i = 0; i < 2; ++i) { int R, C; stage_rc(tid * 16 + i * 8192, R, C); const int Rb = Epi::PERM ? ((R & ~31) + perm32(R & 31)) : R;
        voffA[i] = (unsigned)(R * g.lda + C) * 2u; voffB[i] = (unsigned)(Rb * g.ldb + C) * 2u; }
    const size_t kstep = (size_t)(BK * 2);
    const size_t hstepA = (size_t)HALF * g.lda * 2, hstepB = (size_t)HALF * g.ldb * 2;
    const unsigned ldsw = (unsigned)wid * 1024u;
    const int aoff = lds_byte(wr * 64 + fr, fq * 8), boff = lds_byte(wc * 32 + fr, fq * 8);
#define PG8_SA(b, h) (((b) * 2 + (h)) * HTB)
#define PG8_SB(b, h) ((4 + (b) * 2 + (h)) * HTB)
#define PG8_STAGE(bufoff, gbase, voff) do { _Pragma("unroll") for (int _i = 0; _i < 2; ++_i) \
        __builtin_amdgcn_global_load_lds((const unsigned*)((const char*)(gbase) + (voff)[_i]), (PG8_LAS unsigned*)(lds + (bufoff) + ldsw + _i * 8192), 16, 0, 0); } while (0)
#define PG8_LDA(dst, b, h) do { _Pragma("unroll") for (int m = 0; m < 4; ++m) _Pragma("unroll") for (int k = 0; k < 2; ++k) dst[m][k] = *(const PG8_LAS bf16x8*)(lds + PG8_SA(b, h) + aoff + m * 2048 + k * 1024); } while (0)
#define PG8_LDB(dst, b, h) do { _Pragma("unroll") for (int n = 0; n < 2; ++n) _Pragma("unroll") for (int k = 0; k < 2; ++k) dst[n][k] = *(const PG8_LAS bf16x8*)(lds + PG8_SB(b, h) + boff + n * 2048 + k * 1024); } while (0)
#define PG8_MMA(ai, bj, At, Bt) do { __builtin_amdgcn_s_setprio(1); _Pragma("unroll") for (int m = 0; m < 4; ++m) _Pragma("unroll") for (int n = 0; n < 2; ++n) _Pragma("unroll") for (int k = 0; k < 2; ++k) \
        acc[ai][bj][m][n] = __builtin_amdgcn_mfma_f32_16x16x32_bf16(Bt[n][k], At[m][k], acc[ai][bj][m][n], 0, 0, 0); __builtin_amdgcn_s_setprio(0); } while (0)
#define PG8_WAIT_V(n) asm volatile("s_waitcnt vmcnt(" #n ")" ::: "memory")
#define PG8_WAIT_L(n) asm volatile("s_waitcnt lgkmcnt(" #n ")" ::: "memory")
#define PG8_BAR __builtin_amdgcn_s_barrier()
#define PG8_SCHED __builtin_amdgcn_sched_barrier(0)
    Unit cur, nxt; int ui = 0;
    if (!S.next(0, cur)) return;
    f32x4 acc[2][2][4][2];
#pragma unroll
    for (int a = 0; a < 2; ++a)
#pragma unroll
        for (int b = 0; b < 2; ++b)
#pragma unroll
            for (int m = 0; m < 4; ++m)
#pragma unroll
                for (int n = 0; n < 2; ++n) acc[a][b][m][n] = (f32x4){0.f, 0.f, 0.f, 0.f};
    bf16x8 At[4][2], B0[2][2], B1[2][2];
    const char* cA = (const char*)g.A + cur.aoff; const char* cB = (const char*)g.Bt + cur.boff;
    if constexpr (SP2) {
        PG8_STAGE(PG8_SB(0, 0), cB, voffB); PG8_STAGE(PG8_SB(0, 1), cB + hstepB, voffB); PG8_STAGE(PG8_SA(0, 0), cA, voffA); PG8_STAGE(PG8_SA(0, 1), cA + hstepA, voffA);
        if (wr == 1) PG8_BAR;
        PG8_WAIT_V(2); PG8_BAR;
        PG8_STAGE(PG8_SB(1, 0), cB + kstep, voffB); PG8_STAGE(PG8_SA(1, 0), cA + kstep, voffA); PG8_STAGE(PG8_SB(1, 1), cB + hstepB + kstep, voffB);
        PG8_WAIT_V(6); PG8_BAR;
    } else {
        PG8_STAGE(PG8_SB(0, 0), cB, voffB); PG8_STAGE(PG8_SA(0, 0), cA, voffA); PG8_STAGE(PG8_SB(0, 1), cB + hstepB, voffB); PG8_STAGE(PG8_SA(0, 1), cA + hstepA, voffA);
        if (wr == 1) PG8_BAR;
        PG8_WAIT_V(4); PG8_BAR;
        PG8_STAGE(PG8_SB(1, 0), cB + kstep, voffB); PG8_STAGE(PG8_SA(1, 0), cA + kstep, voffA); PG8_STAGE(PG8_SB(1, 1), cB + hstepB + kstep, voffB);
        PG8_WAIT_V(6); PG8_BAR;
    }
    for (;;) {
        const bool has_next = S.next(ui + 1, nxt);
        const char* nA = has_next ? (const char*)g.A + nxt.aoff : cA; const char* nB = has_next ? (const char*)g.Bt + nxt.boff : cB;
        for (int t = 0; t < nt; t += 2) {
            const bool last = (t == nt - 2);
            const char* a1 = cA + (size_t)(t + 1) * kstep;
            const char* a2 = last ? nA : cA + (size_t)(t + 2) * kstep; const char* b2 = last ? nB : cB + (size_t)(t + 2) * kstep;
            const char* a3 = a2 + kstep; const char* b3 = b2 + kstep;
            if constexpr (SP2) {
            PG8_LDB(B0, 0, 0); PG8_LDB(B1, 0, 1); PG8_SCHED; PG8_LDA(At, 0, 0); PG8_STAGE(PG8_SA(1, 1), a1 + hstepA, voffA);
            PG8_WAIT_V(8); PG8_WAIT_L(0); PG8_BAR; PG8_MMA(0, 0, At, B0); PG8_MMA(0, 1, At, B1); PG8_BAR; PG8_SCHED;
            PG8_LDA(At, 0, 1); PG8_STAGE(PG8_SB(0, 0), b2, voffB); PG8_STAGE(PG8_SB(0, 1), b2 + hstepB, voffB); PG8_STAGE(PG8_SA(0, 0), a2, voffA);
            PG8_WAIT_V(8); PG8_WAIT_L(0); PG8_BAR; PG8_MMA(1, 0, At, B0); PG8_MMA(1, 1, At, B1); PG8_BAR; PG8_SCHED;
            PG8_LDB(B0, 1, 0); PG8_LDB(B1, 1, 1); PG8_SCHED; PG8_LDA(At, 1, 0); PG8_STAGE(PG8_SA(0, 1), a2 + hstepA, voffA);
            PG8_WAIT_V(8); PG8_WAIT_L(0); PG8_BAR; PG8_MMA(0, 0, At, B0); PG8_MMA(0, 1, At, B1); PG8_BAR; PG8_SCHED;
            PG8_LDA(At, 1, 1); PG8_STAGE(PG8_SB(1, 0), b3, voffB); PG8_STAGE(PG8_SB(1, 1), b3 + hstepB, voffB); PG8_STAGE(PG8_SA(1, 0), a3, voffA);
            PG8_WAIT_V(8); PG8_WAIT_L(0); PG8_BAR; PG8_MMA(1, 0, At, B0); PG8_MMA(1, 1, At, B1); PG8_BAR; PG8_SCHED;
            } else {
            PG8_LDB(B0, 0, 0); PG8_SCHED; PG8_LDA(At, 0, 0); PG8_STAGE(PG8_SA(1, 1), a1 + hstepA, voffA);
            PG8_WAIT_L(8); PG8_BAR; PG8_WAIT_L(0); PG8_MMA(0, 0, At, B0); PG8_BAR; PG8_SCHED;
            PG8_LDB(B1, 0, 1); PG8_STAGE(PG8_SB(0, 0), b2, voffB);
            PG8_BAR; PG8_WAIT_L(0); PG8_MMA(0, 1, At, B1); PG8_BAR;
            PG8_LDA(At, 0, 1); PG8_STAGE(PG8_SA(0, 0), a2, voffA);
            PG8_BAR; PG8_WAIT_L(0); PG8_MMA(1, 0, At, B0); PG8_BAR; PG8_SCHED;
            PG8_STAGE(PG8_SB(0, 1), b2 + hstepB, voffB);
            PG8_WAIT_V(6); PG8_BAR; PG8_MMA(1, 1, At, B1); PG8_BAR;
            PG8_LDB(B0, 1, 0); PG8_SCHED; PG8_LDA(At, 1, 0); PG8_STAGE(PG8_SA(0, 1), a2 + hstepA, voffA);
            PG8_WAIT_L(8); PG8_BAR; PG8_WAIT_L(0); PG8_MMA(0, 0, At, B0); PG8_BAR; PG8_SCHED;
            PG8_LDB(B1, 1, 1); PG8_STAGE(PG8_SB(1, 0), b3, voffB);
            PG8_BAR; PG8_WAIT_L(0); PG8_MMA(0, 1, At, B1); PG8_BAR;
            PG8_LDA(At, 1, 1); PG8_STAGE(PG8_SA(1, 0), a3, voffA);
            PG8_BAR; PG8_WAIT_L(0); PG8_MMA(1, 0, At, B0); PG8_BAR; PG8_SCHED;
            PG8_STAGE(PG8_SB(1, 1), b3 + hstepB, voffB);
            PG8_WAIT_V(6); PG8_BAR; PG8_MMA(1, 1, At, B1); PG8_BAR;
            }
        }
        if constexpr (ALIGN_EPI) { if (wr == 0) PG8_BAR; }
        E(acc, cur, wr, wc, fr, fq);
        if (!has_next) break;
        if (E.zero_after(cur)) {
#pragma unroll
        for (int a = 0; a < 2; ++a)
#pragma unroll
            for (int b = 0; b < 2; ++b)
#pragma unroll
                for (int m = 0; m < 4; ++m)
#pragma unroll
                    for (int n = 0; n < 2; ++n) acc[a][b][m][n] = (f32x4){0.f, 0.f, 0.f, 0.f};
        }
        cur = nxt; cA = nA; cB = nB; ++ui;
        if constexpr (ALIGN_EPI) { if (wr == 1) PG8_BAR; }
    }
    PG8_WAIT_V(0);
    if constexpr (!ALIGN_EPI) { if (wr == 0) PG8_BAR; }
    PG8_BAR;
#undef PG8_SA
#undef PG8_SB
#undef PG8_STAGE
#undef PG8_LDA
#undef PG8_LDB
#undef PG8_MMA
#undef PG8_WAIT_V
#undef PG8_WAIT_L
#undef PG8_BAR
#undef PG8_SCHED
}

__device__ __forceinline__ void tile_map(int L, int nM, int nN, int& pm, int& pn) {
    const int nwg = nM * nN; int wgid = L;
    { const int q = nwg / NXCD, r = nwg % NXCD, xcd = wgid % NXCD, off = wgid / NXCD; wgid = (xcd < r ? xcd * (q + 1) : r * (q + 1) + (xcd - r) * q) + off; }
    const int nig = WGM * nN, gid = wgid / nig, fm = gid * WGM, gsz = (nM - fm) < WGM ? (nM - fm) : WGM;
    pm = fm + ((wgid % nig) % gsz); pn = (wgid % nig) / gsz;
}
struct SchedPlain {
    int nM, nN, G, c; size_t astride, bstride;
    __device__ __forceinline__ bool next(int i, Unit& u) const {
        const long L = (long)i * G + c; if (L >= (long)nM * nN) return false;
        tile_map((int)L, nM, nN, u.pm, u.pn); u.sub = 0; u.aoff = (size_t)u.pm * astride; u.boff = (size_t)u.pn * bstride; return true;
    }
};
struct SchedBranch {
    int nM, nN, G, c;
    __device__ __forceinline__ bool next(int i, Unit& u) const {
        const int t = i / 3, s = i - 3 * t; const long L = (long)t * G + c; if (L >= (long)nM * nN) return false;
        tile_map((int)L, nM, nN, u.pm, u.pn); u.sub = s;
        u.aoff = (size_t)u.pm * (256 * 1536 * 2) + (size_t)s * (512 * 2); u.boff = ((size_t)s * 1024 + (size_t)u.pn * 256) * (512 * 2); return true;
    }
};

__device__ __forceinline__ float row_rstd(const float* slots, int row) {
    const f32x4* sp = (const f32x4*)(slots + (size_t)row * 16);
    const f32x4 s = (sp[0] + sp[1]) + (sp[2] + sp[3]);
    return rsqrtf(((s[0] + s[1]) + (s[2] + s[3])) * (1.0f / 1024.0f) + 1e-6f);
}
__device__ __forceinline__ float sigmoid_c(float z) { z = fminf(fmaxf(z, -30.f), 30.f); return __builtin_amdgcn_rcpf(1.0f + __expf(-z)); }

struct EpiAct {
    static constexpr bool PERM = true, AFTER_DRAIN = false;
    bf16_t* O; int ldc; const float* slots; int mode; PG8_LAS float* R;
    __device__ __forceinline__ bool zero_after(const Unit&) const { return true; }
    __device__ __forceinline__ void operator()(f32x4 (&acc)[2][2][4][2], const Unit& u, int wr, int wc, int fr_, int fq_) const {
        int fr = fr_, fq = fq_; asm volatile("" : "+v"(fr), "+v"(fq));
        { const int tl = (wr * 4 + wc) * 64 + fq * 16 + fr; if (tl < 256) R[tl] = row_rstd(slots, u.pm * BM + tl); }
        asm volatile("s_waitcnt vmcnt(0) lgkmcnt(0)" ::: "memory"); __builtin_amdgcn_s_barrier(); asm volatile("" ::: "memory");
        const int row0 = u.pm * BM + wr * 64 + fr, col0 = u.pn * BM + wc * 32 + 8 * fq;
        const int act = (mode == 1) ? 2 : ((mode == 0 && u.pn < 4) ? 1 : 0);
#pragma unroll
        for (int ai = 0; ai < 2; ++ai)
#pragma unroll
            for (int m = 0; m < 4; ++m) {
                const int row = row0 + ai * HALF + m * 16; const float rs = R[ai * HALF + wr * 64 + m * 16 + fr];
                bf16_t* rowp = O + (size_t)row * ldc + col0;
#pragma unroll
                for (int bj = 0; bj < 2; ++bj) {
                    f32x4 v0 = acc[ai][bj][m][0] * rs, v1 = acc[ai][bj][m][1] * rs;
                    if (act == 1) { f32x2 a = gelu_pk((f32x2){v0[0], v0[1]}), b = gelu_pk((f32x2){v0[2], v0[3]}), c = gelu_pk((f32x2){v1[0], v1[1]}), d = gelu_pk((f32x2){v1[2], v1[3]});
                        v0 = (f32x4){a.x, a.y, b.x, b.y}; v1 = (f32x4){c.x, c.y, d.x, d.y}; }
                    else if (act == 2) { v0 = (f32x4){sigmoid_c(v0[0]), sigmoid_c(v0[1]), sigmoid_c(v0[2]), sigmoid_c(v0[3])}; v1 = (f32x4){sigmoid_c(v1[0]), sigmoid_c(v1[1]), sigmoid_c(v1[2]), sigmoid_c(v1[3])}; }
                    u32x4 w; w.x = cvt_pk_bf16(v0[0], v0[1]); w.y = cvt_pk_bf16(v0[2], v0[3]); w.z = cvt_pk_bf16(v1[0], v1[1]); w.w = cvt_pk_bf16(v1[2], v1[3]);
                    *(u32x4*)(rowp + bj * HALF) = w; }
            }
    }
};
__device__ __forceinline__ void unpack8(const u32x4 v, float (&f)[8]) {
    f[0] = __uint_as_float(v.x << 16); f[1] = __uint_as_float(v.x & 0xffff0000u); f[2] = __uint_as_float(v.y << 16); f[3] = __uint_as_float(v.y & 0xffff0000u);
    f[4] = __uint_as_float(v.z << 16); f[5] = __uint_as_float(v.z & 0xffff0000u); f[6] = __uint_as_float(v.w << 16); f[7] = __uint_as_float(v.w & 0xffff0000u);
}
struct EpiGate {
    static constexpr bool PERM = true, AFTER_DRAIN = false;
    const bf16_t* Gt; bf16_t* O;
    __device__ __forceinline__ bool zero_after(const Unit& u) const { return u.sub == 2; }
    __device__ __forceinline__ void operator()(f32x4 (&acc)[2][2][4][2], const Unit& u, int wr, int wc, int fr_, int fq_) const {
        int fr = fr_, fq = fq_; asm volatile("" : "+v"(fr), "+v"(fq));
        const int row0 = u.pm * BM + wr * 64 + fr, col0 = u.pn * BM + wc * 32 + 8 * fq; const int s = u.sub;
        u32x4 ga[2][2], gb[2][2];
#define GATE_LOAD(st, g) do { const bf16_t* gp_ = Gt + (size_t)(row0 + ((g) >> 2) * HALF + ((g) & 3) * 16) * 3072 + s * 1024 + col0; \
            ga[st][0] = *(const u32x4*)(gp_); ga[st][1] = *(const u32x4*)(gp_ + HALF); \
            if (s < 2) { gb[st][0] = *(const u32x4*)(gp_ + 1024); gb[st][1] = *(const u32x4*)(gp_ + 1024 + HALF); } else { gb[st][0] = ga[st][0]; gb[st][1] = ga[st][1]; } } while (0)
        GATE_LOAD(0, 0);
#pragma unroll
        for (int g = 0; g < 8; ++g) {
            const int ai = g >> 2, m = g & 3, st = g & 1;
            if (g + 1 < 8) GATE_LOAD(st ^ 1, g + 1);
            __builtin_amdgcn_sched_barrier(0);
            const int row = row0 + ai * HALF + m * 16;
#pragma unroll
            for (int bj = 0; bj < 2; ++bj) {
                const int col = col0 + bj * HALF;
                float f[8]; unpack8(ga[st][bj], f);
                if (s < 2) { float h[8]; unpack8(gb[st][bj], h);
#pragma unroll
                    for (int e = 0; e < 8; ++e) f[e] *= __builtin_amdgcn_rcpf(h[e]); }
                f32x4 v0 = acc[ai][bj][m][0], v1 = acc[ai][bj][m][1];
                v0 = v0 * (f32x4){f[0], f[1], f[2], f[3]}; v1 = v1 * (f32x4){f[4], f[5], f[6], f[7]};
                acc[ai][bj][m][0] = v0; acc[ai][bj][m][1] = v1;
                if (s == 2) { u32x4 w; w.x = cvt_pk_bf16(v0[0], v0[1]); w.y = cvt_pk_bf16(v0[2], v0[3]); w.z = cvt_pk_bf16(v1[0], v1[1]); w.w = cvt_pk_bf16(v1[2], v1[3]);
                    *(u32x4*)(O + (size_t)row * 1024 + col) = w; }
            }
            __builtin_amdgcn_sched_barrier(0);
        }
#undef GATE_LOAD
        __builtin_amdgcn_s_waitcnt(0x0F70);
    }
};
struct EpiRes {
    static constexpr bool PERM = true, AFTER_DRAIN = false;
    bf16_t* XB; float* slots;
    __device__ __forceinline__ bool zero_after(const Unit&) const { return true; }
    __device__ __forceinline__ void operator()(f32x4 (&acc)[2][2][4][2], const Unit& u, int wr, int wc, int fr_, int fq_) const {
        int fr = fr_, fq = fq_; asm volatile("" : "+v"(fr), "+v"(fq));
        const int row0 = u.pm * BM + wr * 64 + fr, col0 = u.pn * BM + wc * 32 + 8 * fq;
        u32x4 xs[2][2];
#define RES_LOAD(st, g) do { const bf16_t* p_ = XB + (size_t)(row0 + ((g) >> 2) * HALF + ((g) & 3) * 16) * 1024 + col0; \
            xs[st][0] = *(const u32x4*)(p_); xs[st][1] = *(const u32x4*)(p_ + HALF); } while (0)
        RES_LOAD(0, 0);
#pragma unroll
        for (int g = 0; g < 8; ++g) {
            const int ai = g >> 2, m = g & 3, st = g & 1;
            if (g + 1 < 8) RES_LOAD(st ^ 1, g + 1);
            __builtin_amdgcn_sched_barrier(0);
            const int row = row0 + ai * HALF + m * 16; const size_t off = (size_t)row * 1024 + col0; float ss = 0.f;
#pragma unroll
            for (int bj = 0; bj < 2; ++bj) {
                float f[8]; unpack8(xs[st][bj], f);
                const f32x4 v0 = (f32x4){f[0], f[1], f[2], f[3]} + acc[ai][bj][m][0], v1 = (f32x4){f[4], f[5], f[6], f[7]} + acc[ai][bj][m][1];
                ss += ((v0[0] * v0[0] + v0[1] * v0[1]) + (v0[2] * v0[2] + v0[3] * v0[3])) + ((v1[0] * v1[0] + v1[1] * v1[1]) + (v1[2] * v1[2] + v1[3] * v1[3]));
                u32x4 w; w.x = cvt_pk_bf16(v0[0], v0[1]); w.y = cvt_pk_bf16(v0[2], v0[3]); w.z = cvt_pk_bf16(v1[0], v1[1]); w.w = cvt_pk_bf16(v1[2], v1[3]);
                *(u32x4*)(XB + off + bj * HALF) = w; }
            ss += __shfl_xor(ss, 16); ss += __shfl_xor(ss, 32);
            if (fq == 0) slots[(size_t)row * 16 + u.pn * 4 + wc] = ss;
            __builtin_amdgcn_sched_barrier(0);
        }
#undef RES_LOAD
    }
};
struct SchedConv {
    int G, c;
    __device__ __forceinline__ bool next(int i, Unit& u) const {
        const long L = (long)i * G + c; if (L >= 65L * 22L) return false;
        tile_map((int)L, 65, 22, u.pm, u.pn); u.sub = 0;
        u.aoff = (size_t)((long)(254 * u.pm - 2) * 2048L); u.boff = (size_t)u.pn * (256 * 1024 * 2); return true;
    }
};
__device__ __forceinline__ float dpp_f(float oldv, float src, const int ctrl_sel) {
    const int o = __float_as_int(oldv), v = __float_as_int(src);
    return __int_as_float(ctrl_sel == 1 ? __builtin_amdgcn_update_dpp(o, v, 0x111, 0xf, 0xf, false) : __builtin_amdgcn_update_dpp(o, v, 0x112, 0xf, 0xf, false));
}
__device__ __forceinline__ float ror_f(float src, const int n) {
    const int v = __float_as_int(src);
    return __int_as_float(n == 1 ? __builtin_amdgcn_mov_dpp(v, 0x121, 0xf, 0xf, false) : __builtin_amdgcn_mov_dpp(v, 0x122, 0xf, 0xf, false));
}
struct EpiConv {
    static constexpr bool PERM = true, AFTER_DRAIN = false;
    bf16_t* ACT; const float* slots; const float* cw; PG8_LAS float* H;
    __device__ __forceinline__ bool zero_after(const Unit&) const { return true; }
    __device__ __forceinline__ void operator()(f32x4 (&acc)[2][2][4][2], const Unit& u, int wr, int wc, int fr_, int fq_) const {
        int fr = fr_, fq = fq_; asm volatile("" : "+v"(fr), "+v"(fq));
        const int arow0 = 254 * u.pm - 2, cl = wc * 32 + 8 * fq;
        PG8_LAS float* R = H + 3 * 2 * 256;
        PG8_LAS float* CWl = R + 256;
        { const int tl = (wr * 4 + wc) * 64 + fq * 16 + fr;
          if (tl < 256) { int row = arow0 + tl; row = row < 0 ? 0 : (row > 16383 ? 16383 : row); R[tl] = row_rstd(slots, row); }
          else if (tl < 448) { const int k = (tl - 256) >> 6, col = ((tl - 256) & 63) * 4; *(PG8_LAS f32x4*)(CWl + k * 256 + col) = *(const f32x4*)(cw + k * 5632 + (col < 128 ? 128 * u.pn + col : 2816 + 128 * u.pn + col - 128)); } }
#pragma unroll
        for (int ai = 0; ai < 2; ++ai) { const int s = 2 * ai + wr;
            if (s < 3 && fr >= 14) {
#pragma unroll
                for (int bj = 0; bj < 2; ++bj)
#pragma unroll
                    for (int n = 0; n < 2; ++n) *(PG8_LAS f32x4*)(H + (s * 2 + (fr - 14)) * 256 + bj * HALF + cl + 4 * n) = acc[ai][bj][3][n]; } }
        asm volatile("s_waitcnt vmcnt(0) lgkmcnt(0)" ::: "memory"); __builtin_amdgcn_s_barrier(); asm volatile("" ::: "memory");
#pragma unroll
        for (int ai = 0; ai < 2; ++ai)
#pragma unroll
            for (int m = 0; m < 4; ++m) { const float rs = R[ai * HALF + wr * 64 + m * 16 + fr];
#pragma unroll
                for (int bj = 0; bj < 2; ++bj) { acc[ai][bj][m][0] = acc[ai][bj][m][0] * rs; acc[ai][bj][m][1] = acc[ai][bj][m][1] * rs; } }
        const int tbg = (arow0 + wr * 64) & 8191; const bool gedge = (tbg >= 8177) || (tbg <= 1);
#pragma unroll
        for (int n = 0; n < 2; ++n) {
            f32x4 wg[3], wv[3];
#pragma unroll
            for (int k = 0; k < 3; ++k) { wg[k] = *(const PG8_LAS f32x4*)(CWl + k * 256 + cl + 4 * n); wv[k] = *(const PG8_LAS f32x4*)(CWl + k * 256 + 128 + cl + 4 * n); }
#pragma unroll
            for (int ai = 0; ai < 2; ++ai) {
                const int s = 2 * ai + wr;
                f32x4 h1[2], h2[2];
#pragma unroll
                for (int bj = 0; bj < 2; ++bj) {
                    if (s > 0) { h1[bj] = *(const PG8_LAS f32x4*)(H + ((s - 1) * 2 + 1) * 256 + bj * HALF + cl + 4 * n) * R[64 * s - 1]; h2[bj] = *(const PG8_LAS f32x4*)(H + ((s - 1) * 2 + 0) * 256 + bj * HALF + cl + 4 * n) * R[64 * s - 2]; }
                    else { h1[bj] = (f32x4){0.f, 0.f, 0.f, 0.f}; h2[bj] = (f32x4){0.f, 0.f, 0.f, 0.f}; } }
#pragma unroll
                for (int m = 0; m < 4; ++m) {
                    const int lr = ai * HALF + wr * 64 + m * 16 + fr, t = arow0 + lr, tb = t & 8191;
                    const bool k1 = tb >= 1, k2 = tb >= 2;
                    float o[4];
#pragma unroll
                    for (int jj = 0; jj < 4; ++jj) {
                        float cv[2];
#pragma unroll
                        for (int bj = 0; bj < 2; ++bj) {
                            const float cur = acc[ai][bj][m][n][jj];
                            float o1, o2;
                            if (m > 0) { const float prv = acc[ai][bj][m - 1][n][jj]; o1 = ror_f(prv, 1); o2 = ror_f(prv, 2); }
                            else { o1 = h1[bj][jj]; o2 = (fr == 0) ? h2[bj][jj] : o1; }
                            float x1 = dpp_f(o1, cur, 1), x2 = dpp_f(o2, cur, 2);
                            if (ai == 0 && m == 0) { x1 = (gedge && !k1) ? 0.f : x1; x2 = (gedge && !k2) ? 0.f : x2; }
                            cv[bj] = bj == 0 ? (wg[0][jj] * x2 + wg[1][jj] * x1 + wg[2][jj] * cur) : (wv[0][jj] * x2 + wv[1][jj] * x1 + wv[2][jj] * cur);
                        }
                        o[jj] = cv[0] * __builtin_amdgcn_rcpf(1.0f + __expf(-cv[0])) * cv[1];
                    }
                    u32x2 pk; pk.x = cvt_pk_bf16(o[0], o[1]); pk.y = cvt_pk_bf16(o[2], o[3]);
                    if (lr >= 2 && t < 16384) *(u32x2*)(ACT + (size_t)t * 2816 + 128 * u.pn + cl + 4 * n) = pk;
                    asm volatile("" ::: "memory");
                }
            }
        }
    }
};
}

#define LAS __attribute__((address_space(3)))
typedef pg8::bf16_t bf16;
typedef pg8::f32x4 f32x4;
typedef pg8::u32x4 u32x4;
typedef pg8::u32x2 u32x2;
typedef pg8::bf16x8 bf16x8;
constexpr int DM = 1024, SEQ = 8192, M = 16384, DEPTH = 2, INC = 6144, DFF = 2816, UPC = 5632;
constexpr size_t MiB = 1u << 20;
constexpr size_t WS_BAR = 16384;
constexpr size_t WS_SLOTS = 1 * MiB;
constexpr size_t WS_WIN = 2 * MiB, WS_WBR = 14 * MiB, WS_WO = 17 * MiB, WS_WUP = 19 * MiB, WS_WDN = 30 * MiB;
constexpr size_t WS_XB = 36 * MiB;
constexpr size_t WS_PA = 68 * MiB;
constexpr size_t WS_Y = 164 * MiB;
constexpr size_t WS_MG = 212 * MiB;
constexpr size_t WS_AP = 68 * MiB;
constexpr size_t WS_ACT = 156 * MiB;
constexpr size_t WS_WUP1 = 244 * MiB, WS_WDN1 = 19 * MiB;
constexpr size_t WS_END = 255 * MiB;
constexpr int LDS_BYTES = 143360, LDS_ST = 143360 - 64;

struct Args { const float* in[18]; float* out; unsigned char* ws; };
enum { I_X = 0, I_NMIX, I_WIN, I_SLN, I_SW, I_SB, I_CBW, I_PW, I_PS, I_WA, I_WB, I_WC, I_WO, I_NFFN, I_WUP, I_FCW, I_WDN, I_NF };

__device__ __forceinline__ int tid_l() { int t = threadIdx.x; asm volatile("" : "+v"(t)); return t; }
__device__ __forceinline__ float wave_sum(float v) {
#pragma unroll
    for (int o = 1; o < 64; o <<= 1) v += __shfl_xor(v, o);
    return v;
}
__device__ __forceinline__ unsigned pk2(float lo, float hi) { return pg8::cvt_pk_bf16(lo, hi); }
__device__ __forceinline__ float bf_lo(unsigned w) { return __uint_as_float(w << 16); }
__device__ __forceinline__ float bf_hi(unsigned w) { return __uint_as_float(w & 0xffff0000u); }

struct TrItem { const float* W; bf16* WT; const float* ksc; int K, N, dst_row0, k0, n0; };
__device__ __forceinline__ void tr_load(const TrItem& t, f32x4 (&v)[16], int lane) {
    const int r = lane >> 4, c4 = (lane & 15) * 4;
#pragma unroll
    for (int i = 0; i < 16; ++i) v[i] = *(const f32x4*)(t.W + (size_t)(t.k0 + 4 * i + r) * t.N + t.n0 + c4);
}
__device__ __forceinline__ void tr_store(const TrItem& t, const f32x4 (&v)[16], LAS float* scr, int lane) {
    const int r = lane >> 4, c4 = (lane & 15) * 4;
#pragma unroll
    for (int i = 0; i < 16; ++i) { const float sc = t.ksc ? t.ksc[t.k0 + 4 * i + r] : 1.0f; LAS float* d = scr + (4 * i + r) * 65 + c4; d[0] = v[i][0] * sc; d[1] = v[i][1] * sc; d[2] = v[i][2] * sc; d[3] = v[i][3] * sc; }
    asm volatile("s_waitcnt lgkmcnt(0)" ::: "memory");
    const int c = lane & 7;
#pragma unroll
    for (int j = 0; j < 8; ++j) { const int n = (lane >> 3) + 8 * j; const LAS float* s = scr + (8 * c) * 65 + n;
        u32x4 o; o.x = pk2(s[0 * 65], s[1 * 65]); o.y = pk2(s[2 * 65], s[3 * 65]); o.z = pk2(s[4 * 65], s[5 * 65]); o.w = pk2(s[6 * 65], s[7 * 65]);
        *(u32x4*)(t.WT + (size_t)(t.dst_row0 + n) * t.K + t.k0 + 8 * c) = o; }
    asm volatile("s_waitcnt lgkmcnt(0)" ::: "memory");
}
constexpr int CI_IN = (DM / 64) * (INC / 64), CI_BR = (512 / 64) * (DM / 64), CI_O = (DM / 64) * (DM / 64), CI_UP = (DM / 64) * (UPC / 64), CI_DN = (DFF / 64) * (DM / 64);
constexpr int CI_A = CI_IN + 3 * CI_BR + CI_O, CI_B = CI_A + CI_UP, CI_ALL = CI_B + CI_DN;
__device__ __forceinline__ TrItem tr_decode(const Args& a, int l, int it) {
    unsigned char* ws = a.ws; TrItem t; int r = it;
    if (r < CI_IN) { const int nblk = INC / 64, kb = r / nblk, nb = r % nblk; t.W = a.in[I_WIN] + (size_t)l * DM * INC; t.K = DM; t.N = INC; t.WT = (bf16*)(ws + WS_WIN); t.dst_row0 = 64 * nb; t.ksc = a.in[I_NMIX] + l * DM; t.k0 = 64 * kb; t.n0 = 64 * nb; return t; } r -= CI_IN;
    if (r < 3 * CI_BR) { const int br = r / CI_BR; r -= br * CI_BR; const int nblk = DM / 64, kb = r / nblk, nb = r % nblk;
        t.W = a.in[I_WA + br] + (size_t)l * 512 * DM; t.K = 512; t.N = DM; t.WT = (bf16*)(ws + WS_WBR); t.dst_row0 = br * 1024 + 64 * nb; t.ksc = nullptr; t.k0 = 64 * kb; t.n0 = 64 * nb; return t; } r -= 3 * CI_BR;
    if (r < CI_O) { const int nblk = DM / 64, kb = r / nblk, nb = r % nblk; t.W = a.in[I_WO] + (size_t)l * DM * DM; t.K = DM; t.N = DM; t.WT = (bf16*)(ws + WS_WO); t.dst_row0 = 64 * nb; t.ksc = nullptr; t.k0 = 64 * kb; t.n0 = 64 * nb; return t; } r -= CI_O;
    if (r < CI_UP) { const int nblk = UPC / 64, kb = r / nblk, nb = r % nblk; const int n0 = 64 * nb; const int j = n0 < DFF ? n0 : n0 - DFF;
        t.W = a.in[I_WUP] + (size_t)l * DM * UPC; t.K = DM; t.N = UPC; t.WT = (bf16*)(ws + (l == 0 ? WS_WUP : WS_WUP1)); t.dst_row0 = 256 * (j / 128) + (j % 128) + (n0 < DFF ? 0 : 128); t.ksc = a.in[I_NFFN] + l * DM; t.k0 = 64 * kb; t.n0 = n0; return t; } r -= CI_UP;
    { const int nblk = DM / 64, kb = r / nblk, nb = r % nblk; t.W = a.in[I_WDN] + (size_t)l * DFF * DM; t.K = DFF; t.N = DM; t.WT = (bf16*)(ws + (l == 0 ? WS_WDN : WS_WDN1)); t.dst_row0 = 64 * nb; t.ksc = nullptr; t.k0 = 64 * kb; t.n0 = 64 * nb; return t; }
}
__device__ __forceinline__ void convert_items(LAS unsigned char* lds, const Args& a, int l, int it_lo, int it_hi, int wk, int nwk) {
    const int tidl = tid_l(), lane = tidl & 63, wave = tidl >> 6;
    LAS float* scr = (LAS float*)(lds + wave * 16640);
    int it = it_lo + wk; if (it >= it_hi) return;
    TrItem cur = tr_decode(a, l, it); f32x4 v[16]; tr_load(cur, v, lane);
    for (;;) {
        const int itn = it + nwk; const bool more = itn < it_hi;
        f32x4 w[16]; TrItem nxt = cur;
        if (more) { nxt = tr_decode(a, l, itn); tr_load(nxt, w, lane); }
        tr_store(cur, v, scr, lane);
        if (!more) break;
#pragma unroll
        for (int i = 0; i < 16; ++i) v[i] = w[i];
        cur = nxt; it = itn;
    }
}
__device__ __forceinline__ void xprep_phase(const Args& a) {
    const int tidl = tid_l(), lane = tidl & 63, wave = tidl >> 6;
    const int gw = blockIdx.x * 8 + wave, NGW = gridDim.x * 8;
    unsigned char* ws = a.ws;
    {
        const float* x = a.in[I_X]; bf16* xb = (bf16*)(ws + WS_XB); float* slots = (float*)(ws + WS_SLOTS);
        for (int m = gw; m < M; m += NGW) {
            const f32x4* xr = (const f32x4*)(x + (size_t)m * DM) + lane; f32x4 v[4]; float s = 0.f;
#pragma unroll
            for (int j = 0; j < 4; ++j) { v[j] = xr[64 * j]; s += (v[j][0] * v[j][0] + v[j][1] * v[j][1]) + (v[j][2] * v[j][2] + v[j][3] * v[j][3]); }
            s = wave_sum(s);
            u32x2* o8 = (u32x2*)(xb + (size_t)m * DM) + lane;
#pragma unroll
            for (int j = 0; j < 4; ++j) { u32x2 w; w.x = pk2(v[j][0], v[j][1]); w.y = pk2(v[j][2], v[j][3]); o8[64 * j] = w; }
            if (lane < 4) { f32x4 z = (f32x4){0.f, 0.f, 0.f, 0.f}; if (lane == 0) z[0] = s; ((f32x4*)(slots + (size_t)m * 16))[lane] = z; }
        }
    }
}

#define LDS_BAR() asm volatile("s_waitcnt lgkmcnt(0)\n\ts_barrier" ::: "memory")
__device__ __forceinline__ void mixer_phase(LAS unsigned char* lds, const Args& a, int l) {
    const int tid = tid_l(), lane = tid & 63, wid = tid >> 6, r16 = lane & 15, q = lane >> 4;
    LAS bf16* Wl = (LAS bf16*)lds;
    LAS bf16* Tl = (LAS bf16*)(lds + 34816);
    LAS float* Fl = (LAS float*)(lds + 69632);
    LAS bf16* Zl = (LAS bf16*)(lds + 70656);
    const bf16* PA = (const bf16*)(a.ws + WS_PA); bf16* Y = (bf16*)(a.ws + WS_Y);
    int cur_job = -1; bool have = false;
    u32x4 pf[5];
#pragma unroll
    for (int k = 0; k < 5; ++k) pf[k] = (u32x4){0u, 0u, 0u, 0u};
    const bool split = (gridDim.x == 256); const int cb = blockIdx.x;
    int sj = 0, srank = 0, sn = 1;
    if (split) { if (cb < 104) { sj = cb / 13; srank = cb % 13; sn = 13; } else if (cb < 168) { sj = 8 + (cb - 104) / 16; srank = (cb - 104) % 16; sn = 16; } else { sj = 12 + (cb - 168) / 22; srank = (cb - 168) % 22; sn = 22; } }
    for (int it = 0;; ++it) {
        int job, blk, jobn, blkn; bool okn;
        if (split) { blk = srank + it * sn; if (blk >= 128) break; job = sj; blkn = blk + sn; okn = blkn < 128; jobn = sj; }
        else { const int u = cb + it * (int)gridDim.x; if (u >= 2048) break; job = u & 15; blk = u >> 4; const int un = u + (int)gridDim.x; okn = un < 2048; jobn = un & 15; blkn = un >> 4; }
        const int R0 = blk * 128; const bool pre = okn && (jobn == job); const int R0n = blkn * 128;
        if (job != cur_job) {
            __syncthreads();
            if (job < 8) {
                const float* W = a.in[I_SW] + (size_t)(l * 8 + job) * 16384;
                for (int idx = tid; idx < 4096; idx += 512) { const int i = idx >> 5, j0 = (idx & 31) * 4; f32x4 w = *(const f32x4*)(W + i * 128 + j0);
                    if (i < 64 && j0 >= 64) w = (f32x4){0.f, 0.f, 0.f, 0.f};
                    u32x2 o; o.x = pk2(w[0], w[1]); o.y = pk2(w[2], w[3]); *(LAS u32x2*)(Wl + i * 136 + j0) = o; }
                if (tid < 128) Fl[tid] = a.in[I_SB][(l * 8 + job) * 128 + tid];
                else if (tid < 192) Fl[tid] = a.in[I_SLN][l * 512 + job * 64 + (tid - 128)];
            } else if (job >= 12) {
                const int g = job - 12; const float* W = a.in[I_PW] + (size_t)(l * 4 + g) * 16384;
                for (int idx = tid; idx < 4096; idx += 512) { const int c = idx & 127, d0 = (idx >> 7) * 4; const f32x4 w = *(const f32x4*)(W + c * 128 + d0);
#pragma unroll
                    for (int e = 0; e < 4; ++e) Wl[(d0 + e) * 136 + c] = (bf16)(pk2(w[e], 0.f) & 0xffffu); }
                if (tid < 128) Fl[tid] = a.in[I_PS][l * 512 + g * 128 + tid];
            }
            __syncthreads();
            cur_job = job; have = false;
        }
        if (job < 8) {
            const int g = job, vrow = tid >> 2, ch0 = (tid & 3) * 16, ui = 16 * wid + r16;
#define SGU_LOAD(R) do { const u32x4* src_ = (const u32x4*)(PA + (size_t)((R) + vrow) * 3072 + 512 + g * 64 + ch0); pf[0] = src_[0]; pf[1] = src_[1]; \
                const bf16* up_ = PA + (size_t)((R) + 16 * wid + (lane >> 3)) * 3072 + g * 64 + 8 * (lane & 7); pf[2] = *(const u32x4*)(up_); pf[3] = *(const u32x4*)(up_ + 8 * 3072); } while (0)
            if (!have) SGU_LOAD(R0);
            const u32x4 cv0 = pf[0], cv1 = pf[1], cu0 = pf[2], cu1 = pf[3];
            if (pre) SGU_LOAD(R0n);
            have = pre;
#undef SGU_LOAD
            {
                float v[16]; { float t0[8], t1[8]; pg8::unpack8(cv0, t0); pg8::unpack8(cv1, t1);
#pragma unroll
                    for (int e = 0; e < 8; ++e) { v[e] = t0[e]; v[8 + e] = t1[e]; } }
                float s = 0.f;
#pragma unroll
                for (int e = 0; e < 16; ++e) s += v[e];
                s += __shfl_xor(s, 1); s += __shfl_xor(s, 2);
                const float mu = s * (1.0f / 64.0f); float s2 = 0.f;
#pragma unroll
                for (int e = 0; e < 16; ++e) { v[e] -= mu; s2 += v[e] * v[e]; }
                s2 += __shfl_xor(s2, 1); s2 += __shfl_xor(s2, 2);
                const float rstd = rsqrtf(s2 * (1.0f / 64.0f) + 1e-6f);
#pragma unroll
                for (int e = 0; e < 16; ++e) Tl[(ch0 + e) * 136 + vrow] = (bf16)(pk2(v[e] * rstd * Fl[128 + ch0 + e], 0.f) & 0xffffu);
            }
            LDS_BAR();
            f32x4 acc[4];
#pragma unroll
            for (int ct = 0; ct < 4; ++ct) acc[ct] = (f32x4){0.f, 0.f, 0.f, 0.f};
#pragma unroll
            for (int ks = 0; ks < 4; ++ks) {
                const bf16x8 bfr = *(const LAS bf16x8*)(Wl + (16 * wid + r16) * 136 + 32 * ks + 8 * q);
#pragma unroll
                for (int ct = 0; ct < 4; ++ct) { const bf16x8 afr = *(const LAS bf16x8*)(Tl + (16 * ct + r16) * 136 + 32 * ks + 8 * q);
                    acc[ct] = __builtin_amdgcn_mfma_f32_16x16x32_bf16(afr, bfr, acc[ct], 0, 0, 0); }
            }
            {
                LAS float* Sl = (LAS float*)Zl;
                const float bias = Fl[ui];
#pragma unroll
                for (int ct = 0; ct < 4; ++ct) *(LAS f32x4*)(Sl + ui * 68 + 16 * ct + 4 * q) = acc[ct] + bias;
                asm volatile("s_waitcnt lgkmcnt(0)" ::: "memory");
#pragma unroll
                for (int k = 0; k < 2; ++k) { const int i = 16 * wid + (lane >> 3) + 8 * k, c8 = 8 * (lane & 7);
                    const f32x4 s0 = *(const LAS f32x4*)(Sl + i * 68 + c8), s1 = *(const LAS f32x4*)(Sl + i * 68 + c8 + 4);
                    float uf[8]; pg8::unpack8(k == 0 ? cu0 : cu1, uf);
                    u32x4 o; o.x = pk2(uf[0] * s0[0], uf[1] * s0[1]); o.y = pk2(uf[2] * s0[2], uf[3] * s0[3]); o.z = pk2(uf[4] * s1[0], uf[5] * s1[1]); o.w = pk2(uf[6] * s1[2], uf[7] * s1[3]);
                    *(u32x4*)(Y + (size_t)(R0 + i) * 1536 + g * 64 + c8) = o; }
            }
            LDS_BAR();
        } else if (job < 12) {
            const int c0 = 128 * (job - 8) + 8 * (tid & 15), gr0 = R0 + 4 * (tid >> 4), tb0 = gr0 & (SEQ - 1);
            const float* cw = a.in[I_CBW] + (size_t)l * 3 * 512 + c0;
            float w0[8], w1[8], w2[8];
            { const f32x4 a0 = *(const f32x4*)(cw), a1 = *(const f32x4*)(cw + 4), b0 = *(const f32x4*)(cw + 512), b1 = *(const f32x4*)(cw + 516), d0 = *(const f32x4*)(cw + 1024), d1 = *(const f32x4*)(cw + 1028);
#pragma unroll
              for (int e = 0; e < 4; ++e) { w0[e] = a0[e]; w0[4 + e] = a1[e]; w1[e] = b0[e]; w1[4 + e] = b1[e]; w2[e] = d0[e]; w2[4 + e] = d1[e]; } }
            float z2[8], z1[8];
#pragma unroll
            for (int e = 0; e < 8; ++e) { z2[e] = 0.f; z1[e] = 0.f; }
            if (tb0 >= 2) { float cgv[8], xv[8]; const bf16* p = PA + (size_t)(gr0 - 2) * 3072 + c0; pg8::unpack8(*(const u32x4*)(p + 1536), cgv); pg8::unpack8(*(const u32x4*)(p + 2048), xv);
#pragma unroll
                for (int e = 0; e < 8; ++e) z2[e] = cgv[e] * xv[e]; }
            if (tb0 >= 1) { float cgv[8], xv[8]; const bf16* p = PA + (size_t)(gr0 - 1) * 3072 + c0; pg8::unpack8(*(const u32x4*)(p + 1536), cgv); pg8::unpack8(*(const u32x4*)(p + 2048), xv);
#pragma unroll
                for (int e = 0; e < 8; ++e) z1[e] = cgv[e] * xv[e]; }
#pragma unroll
            for (int rr = 0; rr < 4; ++rr) {
                const bf16* p = PA + (size_t)(gr0 + rr) * 3072 + c0; float bgv[8], cgv[8], xv[8], o[8];
                pg8::unpack8(*(const u32x4*)(p + 1024), bgv); pg8::unpack8(*(const u32x4*)(p + 1536), cgv); pg8::unpack8(*(const u32x4*)(p + 2048), xv);
#pragma unroll
                for (int e = 0; e < 8; ++e) { const float z0 = cgv[e] * xv[e]; o[e] = bgv[e] * (w0[e] * z2[e] + w1[e] * z1[e] + w2[e] * z0); z2[e] = z1[e]; z1[e] = z0; }
                u32x4 w; w.x = pk2(o[0], o[1]); w.y = pk2(o[2], o[3]); w.z = pk2(o[4], o[5]); w.w = pk2(o[6], o[7]);
                *(u32x4*)(Y + (size_t)(gr0 + rr) * 1536 + 512 + c0) = w;
            }
        } else {
            const int g = job - 12, win = 2 << g, c0 = 8 * (tid & 15), rl0 = 4 * (tid >> 4), tb0 = (R0 + rl0) & (SEQ - 1);
            const bf16* zc = PA + 2560 + 128 * g;
#define POOL_LOAD(R) do { const int tbb_ = ((R) & (SEQ - 1)) - 15; _Pragma("unroll") for (int k = 0; k < 5; ++k) { const int idx_ = tid + 512 * k, row_ = idx_ >> 4, ch_ = idx_ & 15; \
                pf[k] = (idx_ < 2288 && tbb_ + row_ >= 0) ? *(const u32x4*)(zc + (size_t)((R) - 15 + row_) * 3072 + 8 * ch_) : (u32x4){0u, 0u, 0u, 0u}; } } while (0)
            if (!have) POOL_LOAD(R0);
#pragma unroll
            for (int k = 0; k < 5; ++k) { const int idx = tid + 512 * k, row = idx >> 4, ch = idx & 15; if (idx < 2288) *(LAS u32x4*)(Zl + row * 136 + 8 * ch) = pf[k]; }
            if (pre) POOL_LOAD(R0n);
            have = pre;
#undef POOL_LOAD
            LDS_BAR();
            float S[8];
#pragma unroll
            for (int e = 0; e < 8; ++e) S[e] = 0.f;
#pragma unroll
            for (int d = 15; d >= 1; --d) { if (d < win) { float z[8]; pg8::unpack8(*(const LAS u32x4*)(Zl + (15 + rl0 - d) * 136 + c0), z);
#pragma unroll
                for (int e = 0; e < 8; ++e) S[e] += z[e]; } }
#pragma unroll
            for (int rr = 0; rr < 4; ++rr) {
                float z[8]; pg8::unpack8(*(const LAS u32x4*)(Zl + (15 + rl0 + rr) * 136 + c0), z);
#pragma unroll
                for (int e = 0; e < 8; ++e) S[e] += z[e];
                if (rr > 0) { float zo[8]; pg8::unpack8(*(const LAS u32x4*)(Zl + (15 + rl0 + rr - win) * 136 + c0), zo);
#pragma unroll
                    for (int e = 0; e < 8; ++e) S[e] -= zo[e]; }
                const int tb = tb0 + rr; const float inv = 1.0f / (float)((tb + 1) < win ? (tb + 1) : win); float o[8];
#pragma unroll
                for (int e = 0; e < 8; ++e) o[e] = S[e] * inv - z[e];
                u32x4 w; w.x = pk2(o[0], o[1]); w.y = pk2(o[2], o[3]); w.z = pk2(o[4], o[5]); w.w = pk2(o[6], o[7]);
                *(LAS u32x4*)(Tl + (rl0 + rr) * 136 + c0) = w;
            }
            LDS_BAR();
            f32x4 acc[8];
#pragma unroll
            for (int dt = 0; dt < 8; ++dt) acc[dt] = (f32x4){0.f, 0.f, 0.f, 0.f};
#pragma unroll
            for (int ks = 0; ks < 4; ++ks) {
                const bf16x8 bfr = *(const LAS bf16x8*)(Tl + (16 * wid + r16) * 136 + 32 * ks + 8 * q);
#pragma unroll
                for (int dt = 0; dt < 8; ++dt) { const bf16x8 afr = *(const LAS bf16x8*)(Wl + (16 * dt + r16) * 136 + 32 * ks + 8 * q);
                    acc[dt] = __builtin_amdgcn_mfma_f32_16x16x32_bf16(afr, bfr, acc[dt], 0, 0, 0); }
            }
            {
                const int t = 16 * wid + r16;
#pragma unroll
                for (int dt = 0; dt < 8; ++dt) { const int d0 = 16 * dt + 4 * q; const f32x4 sc = *(const LAS f32x4*)(Fl + d0);
                    u32x2 o; o.x = pk2(acc[dt][0] * sc[0], acc[dt][1] * sc[1]); o.y = pk2(acc[dt][2] * sc[2], acc[dt][3] * sc[3]);
                    *(LAS u32x2*)(Tl + t * 136 + d0) = o; }
                asm volatile("s_waitcnt lgkmcnt(0)" ::: "memory");
#pragma unroll
                for (int k = 0; k < 4; ++k) { const int row = 16 * wid + (lane >> 4) + 4 * k, ch = lane & 15;
                    *(u32x4*)(Y + (size_t)(R0 + row) * 1536 + 1024 + 128 * g + 8 * ch) = *(const LAS u32x4*)(Tl + row * 136 + 8 * ch); }
            }
            LDS_BAR();
        }
    }
}

__device__ __forceinline__ void ffn_conv_phase(const Args& a, int l, int half) {
    const bf16* AP = (const bf16*)(a.ws + WS_AP); bf16* ACT = (bf16*)(a.ws + WS_ACT);
    const int gtid = blockIdx.x * 512 + tid_l(), nth = gridDim.x * 512;
    for (int it = gtid; it < 1024 * 11 * 16; it += nth) {
        const int chg = it & 15, tmp = it >> 4, n = tmp % 11, rc = tmp / 11;
        const int jg = 128 * (n + 11 * half) + 8 * chg, cb = 256 * n + 8 * chg, gr0 = 16 * rc, tb0 = gr0 & (SEQ - 1);
        const float* cw = a.in[I_FCW] + (size_t)l * 3 * UPC + jg;
        float wg[3][8], wv[3][8];
#pragma unroll
        for (int k = 0; k < 3; ++k) { const f32x4 g0 = *(const f32x4*)(cw + k * UPC), g1 = *(const f32x4*)(cw + k * UPC + 4), v0 = *(const f32x4*)(cw + k * UPC + DFF), v1 = *(const f32x4*)(cw + k * UPC + DFF + 4);
#pragma unroll
            for (int e = 0; e < 4; ++e) { wg[k][e] = g0[e]; wg[k][4 + e] = g1[e]; wv[k][e] = v0[e]; wv[k][4 + e] = v1[e]; } }
        float g2[8], g1[8], v2[8], v1[8];
#pragma unroll
        for (int e = 0; e < 8; ++e) { g2[e] = 0.f; g1[e] = 0.f; v2[e] = 0.f; v1[e] = 0.f; }
        if (tb0 >= 2) { const bf16* p = AP + (size_t)(gr0 - 2) * DFF + cb; pg8::unpack8(*(const u32x4*)p, g2); pg8::unpack8(*(const u32x4*)(p + 128), v2); }
        if (tb0 >= 1) { const bf16* p = AP + (size_t)(gr0 - 1) * DFF + cb; pg8::unpack8(*(const u32x4*)p, g1); pg8::unpack8(*(const u32x4*)(p + 128), v1); }
#pragma unroll 4
        for (int rr = 0; rr < 16; ++rr) {
            const bf16* p = AP + (size_t)(gr0 + rr) * DFF + cb; float g0[8], v0[8], o[8];
            pg8::unpack8(*(const u32x4*)p, g0); pg8::unpack8(*(const u32x4*)(p + 128), v0);
#pragma unroll
            for (int e = 0; e < 8; ++e) {
                const float ag = wg[0][e] * g2[e] + wg[1][e] * g1[e] + wg[2][e] * g0[e], av = wv[0][e] * v2[e] + wv[1][e] * v1[e] + wv[2][e] * v0[e];
                o[e] = ag * __builtin_amdgcn_rcpf(1.0f + __expf(-ag)) * av;
                g2[e] = g1[e]; g1[e] = g0[e]; v2[e] = v1[e]; v1[e] = v0[e]; }
            u32x4 w; w.x = pk2(o[0], o[1]); w.y = pk2(o[2], o[3]); w.z = pk2(o[4], o[5]); w.w = pk2(o[6], o[7]);
            *(u32x4*)(ACT + (size_t)(gr0 + rr) * DFF + jg) = w;
        }
    }
}

__device__ __forceinline__ void final_norm(const Args& a) {
    const int tidl = tid_l(), lane = tidl & 63, gw = blockIdx.x * 8 + (tidl >> 6), NGW = gridDim.x * 8;
    const f32x4* gp = (const f32x4*)a.in[I_NF] + lane; const bf16* XB = (const bf16*)(a.ws + WS_XB); const float* slots = (const float*)(a.ws + WS_SLOTS);
    f32x4 gv[4];
#pragma unroll
    for (int j = 0; j < 4; ++j) gv[j] = gp[64 * j];
    for (int m = gw; m < M; m += NGW) {
        const u32x2* xr = (const u32x2*)(XB + (size_t)m * DM) + lane; u32x2 v[4];
#pragma unroll
        for (int j = 0; j < 4; ++j) v[j] = xr[64 * j];
        const float rs = pg8::row_rstd(slots, m);
        f32x4* orow = (f32x4*)(a.out + (size_t)m * DM) + lane;
#pragma unroll
        for (int j = 0; j < 4; ++j) orow[64 * j] = (f32x4){bf_lo(v[j].x), bf_hi(v[j].x), bf_lo(v[j].y), bf_hi(v[j].y)} * rs * gv[j];
    }
}

#define XB_TMO      128
#define XB_XCNT(j)  (256  + 64 * (j))
#define XB_XSUB(j)  (1280 + 64 * (j))
#define XB_XGEN(j)  (2304 + 64 * (j))
#define XB_TOP      3328
#define XB_TOPGEN   3392
#define XCD_BAR_WORDS 3456
#define XB_SPIN_CAP (1u << 18)

__device__ __forceinline__ unsigned xb_ld(unsigned* p)              { return __hip_atomic_load(p, __ATOMIC_RELAXED, __HIP_MEMORY_SCOPE_AGENT); }
__device__ __forceinline__ unsigned xb_add(unsigned* p, unsigned v) { return __hip_atomic_fetch_add(p, v, __ATOMIC_RELAXED, __HIP_MEMORY_SCOPE_AGENT); }
__device__ __forceinline__ unsigned xb_xcc_id() { return (unsigned)__builtin_amdgcn_s_getreg((3 << 11) | 20) & 0xFu; }
#define XB_SPIN(cond, bar) do { unsigned _sp = 0; while (cond) { __builtin_amdgcn_s_sleep(1); \
    if ((++_sp & 255u) == 0u) { if (xb_ld(&(bar)[XB_TMO])) break; if (_sp > XB_SPIN_CAP) { atomicAdd(&(bar)[XB_TMO], 1u); break; } } } } while (0)

struct XcdBarrier {
    unsigned* bar; unsigned x;
    volatile LAS unsigned* st;
};

__device__ __forceinline__ XcdBarrier xcd_barrier_post(unsigned* bar, volatile LAS unsigned* st) {
    XcdBarrier b; b.bar = bar; b.x = xb_xcc_id(); b.st = st;
    if (threadIdx.x == 0) (void)xb_add(&bar[XB_XCNT(b.x)], 1u);
    return b;
}
__device__ __forceinline__ void xcd_barrier_complete(unsigned* bar, unsigned x, unsigned& nloc, unsigned& nx) {
    const unsigned G = gridDim.x * gridDim.y * gridDim.z;
    unsigned sum, cnt, mine, sp = 0u;
    for (;;) {
        sum = 0u; cnt = 0u; mine = 0u;
#pragma unroll
        for (unsigned j = 0; j < 16; ++j) { const unsigned c = xb_ld(&bar[XB_XCNT(j)]); sum += c; cnt += (c > 0u) ? 1u : 0u; mine = (j == x) ? c : mine; }
        if (sum == G) break;
        __builtin_amdgcn_s_sleep(1);
        if ((++sp & 255u) == 0u) { if (xb_ld(&bar[XB_TMO])) break; if (sp > XB_SPIN_CAP) { atomicAdd(&bar[XB_TMO], 1u); break; } }
    }
    nloc = mine > 0u ? mine : 1u; nx = cnt > 0u ? cnt : 1u;
}

__device__ __forceinline__ void xcd_barrier(const XcdBarrier& b) {
    asm volatile("s_waitcnt vmcnt(0)" ::: "memory");
    __syncthreads();
    if (threadIdx.x == 0) {
        unsigned* bar = b.bar;
        __builtin_amdgcn_s_waitcnt(0);
        unsigned nloc = b.st[0], nx = b.st[1];
        if (nloc == 0u) { xcd_barrier_complete(bar, b.x, nloc, nx); b.st[0] = nloc; b.st[1] = nx; }
        const unsigned old = xb_add(&bar[XB_XSUB(b.x)], 1u);
        const unsigned gen = old / nloc;
        if (old + 1u == (gen + 1u) * nloc) {
            __builtin_amdgcn_fence(__ATOMIC_RELEASE, "agent");
            asm volatile("s_waitcnt vmcnt(0)" ::: "memory");
            const unsigned og = xb_add(&bar[XB_TOP], 1u);
            const unsigned tg = og / nx;
            if (og + 1u == (tg + 1u) * nx) xb_add(&bar[XB_TOPGEN], 1u);
            else XB_SPIN(xb_ld(&bar[XB_TOPGEN]) == tg, bar);
            __builtin_amdgcn_fence(__ATOMIC_ACQUIRE, "agent");
            xb_add(&bar[XB_XGEN(b.x)], 1u);
            asm volatile("s_waitcnt vmcnt(0)" ::: "memory");
        } else {
            XB_SPIN(xb_ld(&bar[XB_XGEN(b.x)]) == gen, bar);
            __builtin_amdgcn_fence(__ATOMIC_ACQUIRE, "agent");
            asm volatile("s_waitcnt vmcnt(0)" ::: "memory");
        }
    }
    __syncthreads();
}

__global__ void __launch_bounds__(512, 2) fwd_kernel(Args a) {
    extern __shared__ __attribute__((aligned(16))) unsigned char lds_raw[];
    LAS unsigned char* lds = (LAS unsigned char*)lds_raw;
    cg::grid_group grid = cg::this_grid();
    const int G = gridDim.x, c = blockIdx.x;
    unsigned char* ws = a.ws;
    unsigned* barw = (unsigned*)(ws + WS_BAR);
    if (blockIdx.x == 0) for (int i = threadIdx.x; i < XCD_BAR_WORDS; i += 512) barw[i] = 0u;
    if (threadIdx.x < 2) ((volatile LAS unsigned*)(lds + LDS_ST))[threadIdx.x] = 0u;
    grid.sync();
    const XcdBarrier bar = xcd_barrier_post(barw, (volatile LAS unsigned*)(lds + LDS_ST));
    float* slots = (float*)(ws + WS_SLOTS);
    bf16* XB = (bf16*)(ws + WS_XB);
#pragma unroll 1
    for (int l = 0; l < DEPTH; ++l) {
#pragma unroll 1
        for (int ph = 0; ph < 11; ++ph) {
            if (ph == 0) { if (l != 0) continue;
                convert_items(lds, a, 0, 0, CI_ALL, c * 8 + (tid_l() >> 6), G * 8); xprep_phase(a); }
            else if (ph == 7 || ph == 8 || ph == 9) continue;
            else if (ph == 6) {
                pg8::Gemm g{XB, (const bf16*)(ws + (l == 0 ? WS_WUP : WS_WUP1)), DM, DM, DM};
                pg8::SchedConv S{G, c};
                pg8::EpiConv E{(bf16*)(ws + WS_ACT), slots, a.in[I_FCW] + (size_t)l * 3 * UPC, (LAS float*)(lds + 131072)};
                pg8::gemm_phase<pg8::EpiConv, pg8::SchedConv, true, true>(lds, g, S, E);
                if (l + 1 < DEPTH) {
                    const bool idle = (G == 256); const int wv = tid_l() >> 6;
                    if (!idle || c >= 150) convert_items(lds, a, l + 1, 0, CI_B, idle ? (c - 150) * 8 + wv : c * 8 + wv, idle ? 106 * 8 : G * 8);
                }
            }
            else if (ph == 1) {
                const bf16* Bt = (const bf16*)(ws + WS_WIN) + (size_t)0 * DM;
                pg8::Gemm g{XB, Bt, DM, DM, DM};
                pg8::SchedPlain S{M / 256, 3072 / 256, G, c, (size_t)256 * DM * 2, (size_t)256 * DM * 2};
                pg8::EpiAct E{(bf16*)(ws + WS_PA), 3072, slots, 0, (LAS float*)(lds + 131072)};
                pg8::gemm_phase<pg8::EpiAct, pg8::SchedPlain, true, true>(lds, g, S, E);
            }
            else if (ph == 3) {
                const bf16* Bt = (const bf16*)(ws + WS_WIN) + (size_t)3072 * DM;
                pg8::Gemm g{XB, Bt, DM, DM, DM};
                pg8::SchedPlain S{M / 256, 3072 / 256, G, c, (size_t)256 * DM * 2, (size_t)256 * DM * 2};
                pg8::EpiAct E{(bf16*)(ws + WS_PA), 3072, slots, 1, (LAS float*)(lds + 131072)};
                pg8::gemm_phase<pg8::EpiAct, pg8::SchedPlain, true, true>(lds, g, S, E);
            }
            else if (ph == 2) mixer_phase(lds, a, l);
            else if (ph == 4) {
                pg8::Gemm g{(const bf16*)(ws + WS_Y), (const bf16*)(ws + WS_WBR), 1536, 512, 512};
                pg8::SchedBranch S{M / 256, DM / 256, G, c};
                pg8::EpiGate E{(const bf16*)(ws + WS_PA), (bf16*)(ws + WS_MG)};
                pg8::gemm_phase<pg8::EpiGate, pg8::SchedBranch, true, true>(lds, g, S, E);
            }
            else if (ph == 5 || ph == 10) {
                const bool dn = ph == 10;
                pg8::Gemm g{dn ? (const bf16*)(ws + WS_ACT) : (const bf16*)(ws + WS_MG), dn ? (const bf16*)(ws + (l == 0 ? WS_WDN : WS_WDN1)) : (const bf16*)(ws + WS_WO), dn ? DFF : DM, dn ? DFF : DM, dn ? DFF : DM};
                pg8::SchedPlain S{M / 256, DM / 256, G, c, (size_t)256 * (dn ? DFF : DM) * 2, (size_t)256 * (dn ? DFF : DM) * 2};
                pg8::EpiRes E{XB, slots};
                pg8::gemm_phase<pg8::EpiRes, pg8::SchedPlain, true, true>(lds, g, S, E);
                if (dn && l + 1 < DEPTH) convert_items(lds, a, l + 1, CI_B, CI_ALL, c * 8 + (tid_l() >> 6), G * 8);
            }
            xcd_barrier(bar);
        }
    }
    final_norm(a);
}

extern "C" void kernel_launch(void* const* d_in, const int* in_sizes, int n_in, void* d_out, int out_size, void* d_ws, size_t ws_size, hipStream_t stream) {
    static int grid = 0;
    if (grid == 0) {
        if (n_in != 18 || out_size != M * DM || ws_size < WS_END) { fprintf(stderr, "kernel_launch: unexpected shapes (n_in %d, out %d, ws %zu)\n", n_in, out_size, ws_size); grid = -1; return; }
        int dev = 0, cus = 0, per_cu = 0;
        hipGetDevice(&dev); hipDeviceGetAttribute(&cus, hipDeviceAttributeMultiprocessorCount, dev);
        if (hipFuncSetAttribute((const void*)fwd_kernel, hipFuncAttributeMaxDynamicSharedMemorySize, LDS_BYTES) != hipSuccess) { fprintf(stderr, "kernel_launch: hipFuncSetAttribute failed\n"); grid = -1; return; }
        if (hipOccupancyMaxActiveBlocksPerMultiprocessor(&per_cu, (const void*)fwd_kernel, 512, LDS_BYTES) != hipSuccess || per_cu < 1) { fprintf(stderr, "kernel_launch: occupancy query failed (%d)\n", per_cu); grid = -1; return; }
        grid = cus;
    }
    if (grid < 0) return;
    Args a{};
    for (int i = 0; i < 18; ++i) a.in[i] = (const float*)d_in[i];
    a.out = (float*)d_out; a.ws = (unsigned char*)d_ws;
    void* args[] = {&a};
    hipError_t e = hipLaunchCooperativeKernel((const void*)fwd_kernel, dim3(grid), dim3(512), args, LDS_BYTES, stream);
    if (e != hipSuccess) fprintf(stderr, "kernel_launch: cooperative launch failed: %s (grid %d)\n", hipGetErrorString(e), grid);
}
```
